# Optimizing an MI355X kernel written in HIP

```python
import math
import jax, jax.numpy as jnp
from jax import lax
import numpy as np

D_MODEL = 2048
BATCH = 1
SEQ = 8192
DEPTH = 1
DEC_BATCH = 8
DEC_SEQ = 32
PAST_LEN = 2048

CHUNK = 64
H_A = 8
DK_A = 64
DV_A = 2 * DK_A
QK_A = H_A * 2 * DK_A
W_A = H_A * DV_A
H_B = 8
DH_B = 128
W_B = H_B * DH_B
BAND_CHUNKS = 8
BAND_PAST = BAND_CHUNKS * CHUNK
REL_CLIP = 128
T5_BUCKETS = 32
T5_MAX_DIST = 128
Q_BLOCK = 128
EPS = 1e-6

kernel_name = "diff_chunkband_hybrid_stream_step"


def _split_points():
    sizes = (QK_A, QK_A, W_A, W_A, W_B, W_B, W_B, W_B, D_MODEL, D_MODEL)
    pts, acc = [], 0
    for s in sizes[:-1]:
        acc += s
        pts.append(acc)
    return pts


def _in_width():
    return 2 * QK_A + 2 * W_A + 4 * W_B + 2 * D_MODEL


def _rms_norm(x, g):
    xf = x.astype(jnp.float32)
    y = xf * lax.rsqrt(jnp.mean(xf * xf, axis=-1, keepdims=True) + EPS)
    return (y * g.astype(jnp.float32)).astype(x.dtype)


def _t5_bucket(rel):
    half = T5_BUCKETS // 2
    max_exact = half // 2
    ret = jnp.where(rel > 0, half, 0)
    n = jnp.abs(rel)
    nf = jnp.maximum(n, 1).astype(jnp.float32)
    large = max_exact + (jnp.log(nf / max_exact) / math.log(T5_MAX_DIST / max_exact)
                         * (half - max_exact)).astype(jnp.int32)
    large = jnp.minimum(large, half - 1)
    return ret + jnp.where(n < max_exact, n, large)


def _in_proj(h, w_in):
    B, S = h.shape[0], h.shape[1]
    y = jnp.einsum('bsd,de->bse', h, w_in)
    q_a, k_a, v_a, z_a, q_b, k_b, v_b, z_b, g_a, g_b = jnp.split(y, _split_points(), axis=-1)
    return (q_a.reshape(B, S, H_A, 2, DK_A), k_a.reshape(B, S, H_A, 2, DK_A),
            v_a.reshape(B, S, H_A, DV_A), z_a,
            q_b.reshape(B, S, H_B, DH_B), k_b.reshape(B, S, H_B, DH_B),
            v_b.reshape(B, S, H_B, DH_B), z_b, g_a, g_b)


def _diff_core(q, k, v, qpos, kpos, t5_bias, lam, subln_g, lam_init):
    s = jnp.einsum('bqhmd,bkhmd->bhmqk', q, k, preferred_element_type=jnp.float32) * (DK_A ** -0.5)
    bias = jnp.transpose(t5_bias[_t5_bucket(kpos[None, :] - qpos[:, None])], (2, 0, 1))
    mask = (kpos[None, :] // CHUNK) <= (qpos[:, None] // CHUNK)
    s = jnp.where(mask, s + bias[None, :, None].astype(jnp.float32), -jnp.inf)
    p = jax.nn.softmax(s, axis=-1)
    attn = p[:, :, 0] - lam * p[:, :, 1]
    o = jnp.einsum('bhqk,bkhd->bqhd', attn.astype(v.dtype), v, preferred_element_type=jnp.float32)
    o = _rms_norm(o, subln_g) * (1.0 - lam_init)
    return o.astype(q.dtype)


def _band_core(q, k, v, qpos, kpos, rel_bias):
    s = jnp.einsum('bqhd,bkhd->bhqk', q, k, preferred_element_type=jnp.float32) * (DH_B ** -0.5)
    rel = jnp.clip(kpos[None, :] - qpos[:, None], -REL_CLIP, REL_CLIP) + REL_CLIP
    bias = rel_bias[:, rel].astype(jnp.float32)
    qc = qpos // CHUNK
    kc = kpos // CHUNK
    mask = ((kpos[None, :] >= 0) & (kc[None, :] <= qc[:, None])
            & (kc[None, :] >= qc[:, None] - BAND_CHUNKS))
    p = jax.nn.softmax(jnp.where(mask, s + bias[None], -jnp.inf), axis=-1)
    o = jnp.einsum('bhqk,bkhd->bqhd', p.astype(v.dtype), v, preferred_element_type=jnp.float32)
    return o.astype(q.dtype)


def _merge(o_a, z_a, o_b, z_b, g_a, g_b, w_o_a, w_o_b, w_out):
    B, S = o_a.shape[0], o_a.shape[1]
    y_a = jnp.einsum('bse,ed->bsd', o_a.reshape(B, S, W_A) * jax.nn.silu(z_a), w_o_a)
    y_b = jnp.einsum('bse,ed->bsd', o_b.reshape(B, S, W_B) * jax.nn.silu(z_b), w_o_b)
    m = jax.nn.sigmoid(g_a) * y_a + jax.nn.sigmoid(g_b) * y_b
    return jnp.einsum('bsd,de->bse', m, w_out)


def _lambda(lq1, lk1, lq2, lk2, lam_init):
    f = jnp.float32
    return (jnp.exp(jnp.sum(lq1.astype(f) * lk1.astype(f)))
            - jnp.exp(jnp.sum(lq2.astype(f) * lk2.astype(f))) + lam_init)


def _layer_prompt(x, pre_g, post_g, w_in, t5_bias, lam, lam_init, subln_g, rel_bias, w_o_a, w_o_b, w_out):
    B, S = x.shape[0], x.shape[1]
    h = _rms_norm(x, pre_g)
    q_a, k_a, v_a, z_a, q_b, k_b, v_b, z_b, g_a, g_b = _in_proj(h, w_in)
    nb = S // Q_BLOCK
    qa_blocks = jnp.moveaxis(q_a.reshape(B, nb, Q_BLOCK, H_A, 2, DK_A), 1, 0)
    kpos = jnp.arange(S, dtype=jnp.int32)

    def a_block(args):
        qi, i = args
        qpos = i * Q_BLOCK + jnp.arange(Q_BLOCK, dtype=jnp.int32)
        return _diff_core(qi, k_a, v_a, qpos, kpos, t5_bias, lam, subln_g, lam_init)

    o_a = lax.map(a_block, (qa_blocks, jnp.arange(nb, dtype=jnp.int32)))
    o_a = jnp.moveaxis(o_a, 0, 1).reshape(B, S, H_A, DV_A)
    nc = S // CHUNK
    band = BAND_PAST + CHUNK
    kp = jnp.pad(k_b, ((0, 0), (BAND_PAST, 0), (0, 0), (0, 0)))
    vp = jnp.pad(v_b, ((0, 0), (BAND_PAST, 0), (0, 0), (0, 0)))
    qb_chunks = jnp.moveaxis(q_b.reshape(B, nc, CHUNK, H_B, DH_B), 1, 0)

    def b_chunk(args):
        qi, n = args
        start = n * CHUNK
        kb = lax.dynamic_slice_in_dim(kp, start, band, axis=1)
        vb = lax.dynamic_slice_in_dim(vp, start, band, axis=1)
        qpos = start + jnp.arange(CHUNK, dtype=jnp.int32)
        kpos_b = start - BAND_PAST + jnp.arange(band, dtype=jnp.int32)
        return _band_core(qi, kb, vb, qpos, kpos_b, rel_bias)

    o_b = lax.map(b_chunk, (qb_chunks, jnp.arange(nc, dtype=jnp.int32)))
    o_b = jnp.moveaxis(o_b, 0, 1).reshape(B, S, H_B, DH_B)
    y = x + _rms_norm(_merge(o_a, z_a, o_b, z_b, g_a, g_b, w_o_a, w_o_b, w_out), post_g)
    tail = min(BAND_PAST, S)
    return y, k_a.reshape(B, S, 2 * H_A, DK_A), v_a, k_b[:, S - tail:], v_b[:, S - tail:]


def _layer_sample(x, ck_a, cv_a, ck_b, cv_b, pre_g, post_g, w_in, t5_bias, lam, lam_init, subln_g,
                  rel_bias, w_o_a, w_o_b, w_out):
    B, S = x.shape[0], x.shape[1]
    past = ck_a.shape[1]
    win = ck_b.shape[1]
    h = _rms_norm(x, pre_g)
    q_a, k_a, v_a, z_a, q_b, k_b, v_b, z_b, g_a, g_b = _in_proj(h, w_in)
    qpos = past + jnp.arange(S, dtype=jnp.int32)
    k_full = jnp.concatenate([ck_a.reshape(B, past, H_A, 2, DK_A), k_a], axis=1)
    v_full = jnp.concatenate([cv_a, v_a], axis=1)
    kpos = jnp.arange(past + S, dtype=jnp.int32)
    o_a = _diff_core(q_a, k_full, v_full, qpos, kpos, t5_bias, lam, subln_g, lam_init)
    kb = jnp.concatenate([ck_b, k_b], axis=1)
    vb = jnp.concatenate([cv_b, v_b], axis=1)
    kpos_b = past - win + jnp.arange(win + S, dtype=jnp.int32)
    o_b = _band_core(q_b, kb, vb, qpos, kpos_b, rel_bias)
    y = x + _rms_norm(_merge(o_a, z_a, o_b, z_b, g_a, g_b, w_o_a, w_o_b, w_out), post_g)
    return y, k_a.reshape(B, S, 2 * H_A, DK_A), v_a, kb[:, S:], vb[:, S:]


def setup_inputs(seed: int = 0) -> dict:
    key = jax.random.key(seed)
    ks = jax.random.split(key, 20)
    f = jnp.float32
    wb = min(BAND_PAST, PAST_LEN)
    nrm = lambda k, shp, sc: jax.random.normal(k, shp, f) * sc
    return {
        "x_prompt": nrm(ks[0], (BATCH, SEQ, D_MODEL), 1.0),
        "x_sample": nrm(ks[1], (DEC_BATCH, DEC_SEQ, D_MODEL), 1.0),
        "cache_k_a": nrm(ks[2], (DEPTH, DEC_BATCH, PAST_LEN, 2 * H_A, DK_A), 1.0),
        "cache_v_a": nrm(ks[3], (DEPTH, DEC_BATCH, PAST_LEN, H_A, DV_A), 1.0),
        "cache_k_b": nrm(ks[4], (DEPTH, DEC_BATCH, wb, H_B, DH_B), 1.0),
        "cache_v_b": nrm(ks[5], (DEPTH, DEC_BATCH, wb, H_B, DH_B), 1.0),
        "t5_bias": nrm(ks[6], (T5_BUCKETS, H_A), 0.5),
        "pre_norm": 1.0 + nrm(ks[7], (DEPTH, D_MODEL), 0.02),
        "post_norm": 1.0 + nrm(ks[8], (DEPTH, D_MODEL), 0.02),
        "w_in": nrm(ks[9], (DEPTH, D_MODEL, _in_width()), D_MODEL ** -0.5),
        "lambda_q1": nrm(ks[10], (DEPTH, DK_A), 0.1),
        "lambda_k1": nrm(ks[11], (DEPTH, DK_A), 0.1),
        "lambda_q2": nrm(ks[12], (DEPTH, DK_A), 0.1),
        "lambda_k2": nrm(ks[13], (DEPTH, DK_A), 0.1),
        "subln_a": 1.0 + nrm(ks[14], (DEPTH, DV_A), 0.02),
        "rel_bias_b": nrm(ks[15], (DEPTH, H_B, 2 * REL_CLIP + 1), 0.5),
        "w_o_a": nrm(ks[16], (DEPTH, W_A, D_MODEL), W_A ** -0.5),
        "w_o_b": nrm(ks[17], (DEPTH, W_B, D_MODEL), W_B ** -0.5),
        "w_out": nrm(ks[18], (DEPTH, D_MODEL, D_MODEL), D_MODEL ** -0.5),
    }


def reference(x_prompt, x_sample, cache_k_a, cache_v_a, cache_k_b, cache_v_b, t5_bias, pre_norm,
              post_norm, w_in, lambda_q1, lambda_k1, lambda_q2, lambda_k2, subln_a, rel_bias_b,
              w_o_a, w_o_b, w_out):
    yp, ys = x_prompt, x_sample
    kap, vap, kbp, vbp, kas, vas, kbs, vbs = [], [], [], [], [], [], [], []
    for l in range(DEPTH):
        lam_init = 0.8 - 0.6 * math.exp(-0.3 * l)
        lam = _lambda(lambda_q1[l], lambda_k1[l], lambda_q2[l], lambda_k2[l], lam_init)
        yp, ka, va, kb, vb = _layer_prompt(yp, pre_norm[l], post_norm[l], w_in[l], t5_bias, lam, lam_init,
                                           subln_a[l], rel_bias_b[l], w_o_a[l], w_o_b[l], w_out[l])
        kap.append(ka); vap.append(va); kbp.append(kb); vbp.append(vb)
        ys, ka, va, kb, vb = _layer_sample(ys, cache_k_a[l], cache_v_a[l], cache_k_b[l], cache_v_b[l],
                                           pre_norm[l], post_norm[l], w_in[l], t5_bias, lam, lam_init,
                                           subln_a[l], rel_bias_b[l], w_o_a[l], w_o_b[l], w_out[l])
        kas.append(ka); vas.append(va); kbs.append(kb); vbs.append(vb)
    return (yp, ys, jnp.stack(kap), jnp.stack(vap), jnp.stack(kbp), jnp.stack(vbp),
            jnp.stack(kas), jnp.stack(vas), jnp.stack(kbs), jnp.stack(vbs))
```

```cpp
#include <hip/hip_runtime.h>
#include <hip/hip_bf16.h>
#include <cstdio>
#include <cstdint>
namespace pg8 {
#define PG8_LAS __attribute__((address_space(3)))
typedef unsigned short bf16_t;
typedef short bf16x8 __attribute__((ext_vector_type(8)));
typedef float f32x4 __attribute__((ext_vector_type(4)));
typedef unsigned u32x4 __attribute__((ext_vector_type(4)));
constexpr int BM = 256, BK = 64, HALF = 128, HTB = HALF * BK * 2  , STAGE_BYTES = 8 * HTB, NXCD = 8, WGM = 8;

__host__ __device__ __forceinline__ int lds_byte(int r, int c) { const int st = (r >> 4) * 2 + (c >> 5), rr = r & 15, cc = c & 31, ob = rr * 64 + cc * 2; return st * 1024 + (ob ^ (((ob >> 9) & 1) << 5)); }
__host__ __device__ __forceinline__ void stage_rc(int b, int& R, int& C) { const int st = b / 1024, sb = b % 1024, swz = sb ^ (((sb >> 9) & 1) << 5); R = (st >> 1) * 16 + swz / 64; C = (st & 1) * 32 + (swz % 64) / 2; }
__host__ __device__ __forceinline__ int perm32(int rho) { const int n = rho >> 4, i = rho & 15; return 8 * (i >> 2) + 4 * n + (i & 3); }

struct Unit { int pm, pn; };
struct Gemm { const bf16_t* A; const bf16_t* Bt; int M, N, K; };

struct StaticOrder {
    int nM, nN, nwg, G, c;
    __host__ __device__ void init(int M, int N, int G_, int c_) { nM = M / BM; nN = N / BM; nwg = nM * nN; G = G_; c = c_; }
    __host__ __device__ bool next(int i, Unit& u) const {
        const long L = (long)i * G + c; if (L >= nwg) return false;
        int wgid = (int)L; { const int q = nwg / NXCD, r = nwg % NXCD, xcd = wgid % NXCD, off = wgid / NXCD; wgid = (xcd < r ? xcd * (q + 1) : r * (q + 1) + (xcd - r) * q) + off; }
        const int nig = WGM * nN, gid = wgid / nig, fm = gid * WGM, gsz = (nM - fm) < WGM ? (nM - fm) : WGM;
        u.pm = fm + ((wgid % nig) % gsz); u.pn = (wgid % nig) / gsz; return true;
    }
    __device__ __forceinline__ void a_ready(const Unit&) const {}
    __device__ __forceinline__ void done(const Unit&) const {}
};

__device__ __forceinline__ unsigned cvt_pk_bf16(float lo, float hi) { unsigned r; asm volatile("v_cvt_pk_bf16_f32 %0, %1, %2" : "=v"(r) : "v"(lo), "v"(hi)); return r; }
typedef float f32x2 __attribute__((ext_vector_type(2)));
template <class Epi, class Sched, bool ALIGN_EPI = false, bool SP2 = false>
__device__ __forceinline__ void gemm_phase(PG8_LAS unsigned char* lds, const Gemm g, const Sched& S, const Epi& E) {
    const int tid = threadIdx.x, wid = __builtin_amdgcn_readfirstlane(tid >> 6), lane = tid & 63, wr = wid >> 2, wc = wid & 3, fr = lane & 15, fq = lane >> 4;
    const int K = g.K, nt = K / BK;
    unsigned voffA[2], voffB[2];
#pragma unroll
    for (int i = 0; i < 2; ++i) { int R, C; stage_rc(tid * 16 + i * 8192, R, C); const int Rb = Epi::PERM ? ((R & ~31) + perm32(R & 31)) : R;
        voffA[i] = (unsigned)(R * K + C) * 2u; voffB[i] = (unsigned)(Rb * K + C) * 2u; }
    const size_t kstep = (size_t)(BK * 2);
    const size_t hstep = (size_t)HALF * K * 2;
    const size_t tstep = 2 * hstep;
    const unsigned ldsw = (unsigned)wid * 1024u;
    const int aoff = lds_byte(wr * 64 + fr, fq * 8), boff = lds_byte(wc * 32 + fr, fq * 8);
#define PG8_SA(b, h) (((b) * 2 + (h)) * HTB)
#define PG8_SB(b, h) ((4 + (b) * 2 + (h)) * HTB)
#define PG8_STAGE(bufoff, gbase, voff) do { _Pragma("unroll") for (int _i = 0; _i < 2; ++_i) \
        __builtin_amdgcn_global_load_lds((const unsigned*)((const char*)(gbase) + (voff)[_i]), (PG8_LAS unsigned*)(lds + (bufoff) + ldsw + _i * 8192), 16, 0, 0); } while (0)
#define PG8_LDA(dst, b, h) do { _Pragma("unroll") for (int m = 0; m < 4; ++m) _Pragma("unroll") for (int k = 0; k < 2; ++k) dst[m][k] = *(const PG8_LAS bf16x8*)(lds + PG8_SA(b, h) + aoff + m * 2048 + k * 1024); } while (0)
#define PG8_LDB(dst, b, h) do { _Pragma("unroll") for (int n = 0; n < 2; ++n) _Pragma("unroll") for (int k = 0; k < 2; ++k) dst[n][k] = *(const PG8_LAS bf16x8*)(lds + PG8_SB(b, h) + boff + n * 2048 + k * 1024); } while (0)
#define PG8_MMA(ai, bj, At, Bt) do { __builtin_amdgcn_s_setprio(1); _Pragma("unroll") for (int m = 0; m < 4; ++m) _Pragma("unroll") for (int n = 0; n < 2; ++n) _Pragma("unroll") for (int k = 0; k < 2; ++k) \
        acc[ai][bj][m][n] = __builtin_amdgcn_mfma_f32_16x16x32_bf16(Bt[n][k], At[m][k], acc[ai][bj][m][n], 0, 0, 0); __builtin_amdgcn_s_setprio(0); } while (0)
#define PG8_WAIT_V(n) asm volatile("s_waitcnt vmcnt(" #n ")" ::: "memory")
#define PG8_WAIT_L(n) asm volatile("s_waitcnt lgkmcnt(" #n ")" ::: "memory")
#define PG8_BAR __builtin_amdgcn_s_barrier()
#define PG8_SCHED __builtin_amdgcn_sched_barrier(0)
    Unit cur, nxt; int ui = 0;
    if (!S.next(0, cur)) return;
    f32x4 acc[2][2][4][2];
#pragma unroll
    for (int a = 0; a < 2; ++a)
#pragma unroll
        for (int b = 0; b < 2; ++b)
#pragma unroll
            for (int m = 0; m < 4; ++m)
#pragma unroll
                for (int n = 0; n < 2; ++n) acc[a][b][m][n] = (f32x4){0.f, 0.f, 0.f, 0.f};
    bf16x8 At[4][2], B0[2][2], B1[2][2];
    const char* cA = (const char*)g.A + (size_t)cur.pm * tstep; const char* cB = (const char*)g.Bt + (size_t)cur.pn * tstep;
    S.a_ready(cur);
    if constexpr (SP2) {
        PG8_STAGE(PG8_SB(0, 0), cB, voffB); PG8_STAGE(PG8_SB(0, 1), cB + hstep, voffB); PG8_STAGE(PG8_SA(0, 0), cA, voffA); PG8_STAGE(PG8_SA(0, 1), cA + hstep, voffA);
        if (wr == 1) PG8_BAR;
        PG8_WAIT_V(2); PG8_BAR;
        PG8_STAGE(PG8_SB(1, 0), cB + kstep, voffB); PG8_STAGE(PG8_SA(1, 0), cA + kstep, voffA); PG8_STAGE(PG8_SB(1, 1), cB + hstep + kstep, voffB);
        PG8_WAIT_V(6); PG8_BAR;
    } else {
        PG8_STAGE(PG8_SB(0, 0), cB, voffB); PG8_STAGE(PG8_SA(0, 0), cA, voffA); PG8_STAGE(PG8_SB(0, 1), cB + hstep, voffB); PG8_STAGE(PG8_SA(0, 1), cA + hstep, voffA);
        if (wr == 1) PG8_BAR;
        PG8_WAIT_V(4); PG8_BAR;
        PG8_STAGE(PG8_SB(1, 0), cB + kstep, voffB); PG8_STAGE(PG8_SA(1, 0), cA + kstep, voffA); PG8_STAGE(PG8_SB(1, 1), cB + hstep + kstep, voffB);
        PG8_WAIT_V(6); PG8_BAR;
    }
    for (;;) {
        const bool has_next = S.next(ui + 1, nxt);
        const char* nA = has_next ? (const char*)g.A + (size_t)nxt.pm * tstep : cA; const char* nB = has_next ? (const char*)g.Bt + (size_t)nxt.pn * tstep : cB;
        for (int t = 0; t < nt; t += 2) {
            const bool last = (t == nt - 2);
            const char* a1 = cA + (size_t)(t + 1) * kstep;
            const char* a2 = last ? nA : cA + (size_t)(t + 2) * kstep; const char* b2 = last ? nB : cB + (size_t)(t + 2) * kstep;
            const char* a3 = a2 + kstep; const char* b3 = b2 + kstep;
            if (last && has_next) S.a_ready(nxt);
            if constexpr (SP2) {
            PG8_LDB(B0, 0, 0); PG8_LDB(B1, 0, 1); PG8_SCHED; PG8_LDA(At, 0, 0); PG8_STAGE(PG8_SA(1, 1), a1 + hstep, voffA);
            PG8_WAIT_V(8); PG8_WAIT_L(0); PG8_BAR; PG8_MMA(0, 0, At, B0); PG8_MMA(0, 1, At, B1); PG8_BAR; PG8_SCHED;
            PG8_LDA(At, 0, 1); PG8_STAGE(PG8_SB(0, 0), b2, voffB); PG8_STAGE(PG8_SB(0, 1), b2 + hstep, voffB); PG8_STAGE(PG8_SA(0, 0), a2, voffA);
            PG8_WAIT_V(8); PG8_WAIT_L(0); PG8_BAR; PG8_MMA(1, 0, At, B0); PG8_MMA(1, 1, At, B1); PG8_BAR; PG8_SCHED;
            PG8_LDB(B0, 1, 0); PG8_LDB(B1, 1, 1); PG8_SCHED; PG8_LDA(At, 1, 0); PG8_STAGE(PG8_SA(0, 1), a2 + hstep, voffA);
            PG8_WAIT_V(8); PG8_WAIT_L(0); PG8_BAR; PG8_MMA(0, 0, At, B0); PG8_MMA(0, 1, At, B1); PG8_BAR; PG8_SCHED;
            PG8_LDA(At, 1, 1); PG8_STAGE(PG8_SB(1, 0), b3, voffB); PG8_STAGE(PG8_SB(1, 1), b3 + hstep, voffB); PG8_STAGE(PG8_SA(1, 0), a3, voffA);
            PG8_WAIT_V(8); PG8_WAIT_L(0); PG8_BAR; PG8_MMA(1, 0, At, B0); PG8_MMA(1, 1, At, B1); PG8_BAR; PG8_SCHED;
            } else {
            PG8_LDB(B0, 0, 0); PG8_SCHED; PG8_LDA(At, 0, 0); PG8_STAGE(PG8_SA(1, 1), a1 + hstep, voffA);
            PG8_WAIT_L(8); PG8_BAR; PG8_WAIT_L(0); PG8_MMA(0, 0, At, B0); PG8_BAR; PG8_SCHED;
            PG8_LDB(B1, 0, 1); PG8_STAGE(PG8_SB(0, 0), b2, voffB);
            PG8_BAR; PG8_WAIT_L(0); PG8_MMA(0, 1, At, B1); PG8_BAR;
            PG8_LDA(At, 0, 1); PG8_STAGE(PG8_SA(0, 0), a2, voffA);
            PG8_BAR; PG8_WAIT_L(0); PG8_MMA(1, 0, At, B0); PG8_BAR; PG8_SCHED;
            PG8_STAGE(PG8_SB(0, 1), b2 + hstep, voffB);
            PG8_WAIT_V(6); PG8_BAR; PG8_MMA(1, 1, At, B1); PG8_BAR;
            PG8_LDB(B0, 1, 0); PG8_SCHED; PG8_LDA(At, 1, 0); PG8_STAGE(PG8_SA(0, 1), a2 + hstep, voffA);
            PG8_WAIT_L(8); PG8_BAR; PG8_WAIT_L(0); PG8_MMA(0, 0, At, B0); PG8_BAR; PG8_SCHED;
            PG8_LDB(B1, 1, 1); PG8_STAGE(PG8_SB(1, 0), b3, voffB);
            PG8_BAR; PG8_WAIT_L(0); PG8_MMA(0, 1, At, B1); PG8_BAR;
            PG8_LDA(At, 1, 1); PG8_STAGE(PG8_SA(1, 0), a3, voffA);
            PG8_BAR; PG8_WAIT_L(0); PG8_MMA(1, 0, At, B0); PG8_BAR; PG8_SCHED;
            PG8_STAGE(PG8_SB(1, 1), b3 + hstep, voffB);
            PG8_WAIT_V(6); PG8_BAR; PG8_MMA(1, 1, At, B1); PG8_BAR;
            }
        }
        if constexpr (ALIGN_EPI) { if (wr == 0) PG8_BAR; }
        if constexpr (!Epi::AFTER_DRAIN) { E(acc, cur, wr, wc, fr, fq); S.done(cur); }
        if (!has_next) break;
#pragma unroll
        for (int a = 0; a < 2; ++a)
#pragma unroll
            for (int b = 0; b < 2; ++b)
#pragma unroll
                for (int m = 0; m < 4; ++m)
#pragma unroll
                    for (int n = 0; n < 2; ++n) acc[a][b][m][n] = (f32x4){0.f, 0.f, 0.f, 0.f};
        cur = nxt; cA = nA; cB = nB; ++ui;
        if constexpr (ALIGN_EPI) { if (wr == 1) PG8_BAR; }
    }
    PG8_WAIT_V(0);
    if constexpr (!ALIGN_EPI) { if (wr == 0) PG8_BAR; }
    PG8_BAR;
    if constexpr (Epi::AFTER_DRAIN) { E.fused(acc, cur, wr, wc, fr, fq, lds, wid, lane); S.done(cur); }
#undef PG8_SA
#undef PG8_SB
#undef PG8_STAGE
#undef PG8_LDA
#undef PG8_LDB
#undef PG8_MMA
#undef PG8_WAIT_V
#undef PG8_WAIT_L
#undef PG8_BAR
#undef PG8_SCHED
}
}

constexpr int DM = 2048, SEQ = 8192, NSMP = 256, MT = SEQ + NSMP  , NIN = 12288;
constexpr int PAST = 2048, KAS_ROWS = 2112  , KBS_ROWS = 576  ;
constexpr float LOG2E = 1.4426950408889634f;
constexpr float QSCALE_A = 0.125f * LOG2E;
constexpr float QSCALE_B = 0.08838834764831845f * LOG2E;
constexpr size_t O_Y = 0, O_KAP = 17301504, O_VAP = 25690112, O_KBP = 34078720, O_VBP = 34603008, O_KAS = 35127296, O_VAS = 35389440, O_KBS = 35651584, O_VBS = 39845888;


constexpr int NWAVES = 8;
constexpr size_t MiB = 1u << 20;
constexpr size_t WS_CTL = 0, CTL_ZERO_BYTES = 65536;
constexpr size_t WS_SS = 1 * MiB;
constexpr size_t WS_WOT = 2 * MiB;
constexpr size_t WS_WOUTT = 10 * MiB;
constexpr size_t WS_WINT = 18 * MiB;
constexpr size_t WS_XN = 66 * MiB;
constexpr size_t WS_GATED = 18 * MiB;
constexpr size_t WS_Y = 99 * MiB;
constexpr size_t SZ_R = (size_t)MT * 1024 * 2;
constexpr size_t WS_QA = WS_Y, WS_KA = WS_QA + SZ_R, WS_VA = WS_KA + SZ_R, WS_ZA = WS_VA + SZ_R, WS_QB = WS_ZA + SZ_R, WS_KB = WS_QB + SZ_R, WS_VB = WS_KB + SZ_R, WS_ZB = WS_VB + SZ_R;
constexpr size_t WS_GA = WS_ZB + SZ_R, WS_GB = WS_GA + 2 * SZ_R, WS_YEND = WS_GB + 2 * SZ_R;
constexpr size_t WS_MM = WS_Y;
constexpr size_t WS_KAS = 298 * MiB;
constexpr size_t SZ_KAS = (size_t)8 * KAS_ROWS * 1024 * 2, SZ_KBS = (size_t)8 * KBS_ROWS * 1024 * 2;
constexpr size_t WS_VAS = WS_KAS + SZ_KAS, WS_KBS = WS_VAS + SZ_KAS, WS_VBS = WS_KBS + SZ_KBS, WS_DEND = WS_VBS + SZ_KBS;
constexpr size_t WS_PART = WS_KAS;
constexpr size_t WS_END = 384 * MiB;
static_assert(WS_YEND <= WS_KAS && WS_DEND <= WS_END && WS_PART + (size_t)MT * 2048 * 4 <= WS_END && WS_XN + (size_t)MT * 2048 * 2 <= WS_Y && WS_GATED + (size_t)2 * MT * 1024 * 2 <= WS_XN, "d_ws map");
constexpr int CW_QUEUE = 64;
constexpr int CW_BAR = 4096;
constexpr int RING_OFF = 0, RING_BYTES = 131072;
constexpr int MISC_OFF = RING_BYTES;
constexpr int TAB_OFF = RING_BYTES + 256;
constexpr int WSF_OFF = TAB_OFF + 2 * 8 * 192 * 4;
constexpr int LDS_BYTES = 147456;
static_assert(WSF_OFF + 8 * 64 * 4 <= LDS_BYTES, "LDS map");

namespace pg8 {
__device__ __forceinline__ float fast_sigmoid(float v) { return __builtin_amdgcn_rcpf(1.0f + __builtin_amdgcn_exp2f(-v * 1.4426950408889634f)); }
__device__ __forceinline__ float bf2f(unsigned short b) { return __builtin_bit_cast(float, (unsigned)b << 16); }

struct EpiInProj {
    static constexpr bool PERM = true, AFTER_DRAIN = false;
    unsigned char* ws; float* out;
    __device__ __forceinline__ void operator()(const f32x4 (&acc)[2][2][4][2], const Unit& u, int wr, int wc, int fr, int fq) const {
        const int pn = u.pn, T = pn >> 2; const bool smp = (u.pm == 32);
        size_t bbase; int bpitch = 1024, act = 0; float scale = 1.f; size_t fbase = 0; int lc0;
        int brow0 = u.pm * BM + wr * 64 + fr, bSA = 128, bSM = 32;
        int fmode = 0, frow0 = 0, fSA = 128, fSM = 32;
        if (T < 8) {
            lc0 = (pn & 3) * 256 + wc * 32 + 8 * fq;
            bbase = WS_QA + (size_t)T * SZ_R;
            if (T == 0) scale = QSCALE_A; else if (T == 4) scale = QSCALE_B; else if (T == 3 || T == 7) act = 1;
            else if (T == 1 || T == 2) {
                fmode = 1; frow0 = (smp ? 0 : u.pm * BM) + wr * 64 + fr; fbase = (T == 1) ? (smp ? O_KAS : O_KAP) : (smp ? O_VAS : O_VAP);
                if (smp) { bbase = (T == 1) ? WS_KAS : WS_VAS; brow0 = wr * 2 * KAS_ROWS + PAST + fr; bSA = 4 * KAS_ROWS; bSM = KAS_ROWS; }
            } else {
                if (smp) { fmode = 1; frow0 = wr * 2 * 512 + 480 + fr; fSA = 4 * 512; fSM = 512; fbase = (T == 5) ? O_KBS : O_VBS;
                           bbase = (T == 5) ? WS_KBS : WS_VBS; brow0 = wr * 2 * KBS_ROWS + 512 + fr; bSA = 4 * KBS_ROWS; bSM = KBS_ROWS; }
                else if (u.pm >= 30) { fmode = 1; frow0 = u.pm * BM - 7680 + wr * 64 + fr; fbase = (T == 5) ? O_KBP : O_VBP; }
            }
        } else { bpitch = 2048; act = 2; if (pn < 40) { bbase = WS_GA; lc0 = (pn - 32) * 256 + wc * 32 + 8 * fq; } else { bbase = WS_GB; lc0 = (pn - 40) * 256 + wc * 32 + 8 * fq; } }
        bf16_t* const bdst = (bf16_t*)(ws + bbase); float* const fdst = out + fbase;
        const unsigned boff0 = (unsigned)brow0 * (unsigned)bpitch + (unsigned)lc0, bSAo = (unsigned)bSA * (unsigned)bpitch, bSMo = (unsigned)bSM * (unsigned)bpitch, b16 = 16u * (unsigned)bpitch;
        const unsigned foff0 = (unsigned)frow0 * 1024u + (unsigned)lc0, fSAo = (unsigned)fSA * 1024u, fSMo = (unsigned)fSM * 1024u;
#pragma unroll
        for (int ai = 0; ai < 2; ++ai)
#pragma unroll
            for (int m = 0; m < 4; ++m) {
                const unsigned boff = boff0 + ai * bSAo + (m >> 1) * bSMo + (m & 1) * b16;
                const unsigned foff = foff0 + ai * fSAo + (m >> 1) * fSMo + (m & 1) * 16384u;
#pragma unroll
                for (int bj = 0; bj < 2; ++bj) {
                    f32x4 v0 = acc[ai][bj][m][0], v1 = acc[ai][bj][m][1];
                    if (fmode != 0) { float* fp = fdst + (foff + bj * HALF); *(f32x4*)fp = v0; *(f32x4*)(fp + 4) = v1; }
                    if (act == 0) { v0 = v0 * scale; v1 = v1 * scale; }
                    else {
#pragma unroll
                        for (int e = 0; e < 4; ++e) { const float s0 = fast_sigmoid(v0[e]), s1 = fast_sigmoid(v1[e]); v0[e] = (act == 1) ? v0[e] * s0 : s0; v1[e] = (act == 1) ? v1[e] * s1 : s1; }
                    }
                    u32x4 w; w.x = cvt_pk_bf16(v0[0], v0[1]); w.y = cvt_pk_bf16(v0[2], v0[3]); w.z = cvt_pk_bf16(v1[0], v1[1]); w.w = cvt_pk_bf16(v1[2], v1[3]);
                    *(u32x4*)(bdst + (boff + bj * HALF)) = w;
                }
                asm volatile("" ::: "memory");
            }
    }
};

struct EpiMerge {
    static constexpr bool PERM = true, AFTER_DRAIN = false;
    const bf16_t *GA, *GB; float* PART; bf16_t* MMo;
    __device__ __forceinline__ void operator()(const f32x4 (&acc)[2][2][4][2], const Unit& u, int wr, int wc, int fr, int fq) const {
        const int part = (u.pm >= 33) ? 1 : 0, pm = u.pm - 33 * part, pn = u.pn - 8 * part;
        const bf16_t* G = part ? GB : GA;
        const int col0 = pn * BM + wc * 32 + 8 * fq;
#pragma unroll
        for (int ai = 0; ai < 2; ++ai)
#pragma unroll
            for (int m = 0; m < 4; ++m) {
                const size_t row = (size_t)(pm * BM + ai * HALF + wr * 64 + m * 16 + fr);
#pragma unroll
                for (int bj = 0; bj < 2; ++bj) {
                    const size_t off = row * 2048 + col0 + bj * HALF;
                    const u32x4 gw = *(const u32x4*)(G + off);
                    f32x4 g0, g1;
                    g0[0] = __builtin_bit_cast(float, gw.x << 16); g0[1] = __builtin_bit_cast(float, gw.x & 0xffff0000u); g0[2] = __builtin_bit_cast(float, gw.y << 16); g0[3] = __builtin_bit_cast(float, gw.y & 0xffff0000u);
                    g1[0] = __builtin_bit_cast(float, gw.z << 16); g1[1] = __builtin_bit_cast(float, gw.z & 0xffff0000u); g1[2] = __builtin_bit_cast(float, gw.w << 16); g1[3] = __builtin_bit_cast(float, gw.w & 0xffff0000u);
                    f32x4 v0 = acc[ai][bj][m][0] * g0, v1 = acc[ai][bj][m][1] * g1;
                    if (part == 0) { *(f32x4*)(PART + off) = v0; *(f32x4*)(PART + off + 4) = v1; }
                    else {
                        v0 = v0 + *(const f32x4*)(PART + off); v1 = v1 + *(const f32x4*)(PART + off + 4);
                        u32x4 w; w.x = cvt_pk_bf16(v0[0], v0[1]); w.y = cvt_pk_bf16(v0[2], v0[3]); w.z = cvt_pk_bf16(v1[0], v1[1]); w.w = cvt_pk_bf16(v1[2], v1[3]);
                        *(u32x4*)(MMo + off) = w;
                    }
                }
            }
    }
};
struct MergeOrder {
    int c, G;
    __device__ __forceinline__ bool next(int i, Unit& u) const {
        const int ti = i >> 1, part = i & 1; const int L = ti * G + ((G % 8 == 0) ? (c % 8) * (G / 8) + c / 8 : c);
        if (L >= 264) return false;
        u.pm = L / 8 + 33 * part; u.pn = L % 8 + 8 * part; return true;
    }
    __device__ __forceinline__ void a_ready(const Unit&) const {}
    __device__ __forceinline__ void done(const Unit&) const {}
};
struct OutOrder {
    int c, G;
    __device__ __forceinline__ bool next(int i, Unit& u) const {
        const int L = i * G + ((G % 8 == 0) ? (c % 8) * (G / 8) + c / 8 : c);
        if (L >= 264) return false;
        u.pm = L / 8; u.pn = L % 8; return true;
    }
    __device__ __forceinline__ void a_ready(const Unit&) const {}
    __device__ __forceinline__ void done(const Unit&) const {}
};
struct EpiOut {
    static constexpr bool PERM = true, AFTER_DRAIN = false;
    float* Y; float* SS;
    __device__ __forceinline__ void operator()(const f32x4 (&acc)[2][2][4][2], const Unit& u, int wr, int wc, int fr, int fq) const {
        const int col0 = u.pn * BM + wc * 32 + 8 * fq;
#pragma unroll
        for (int ai = 0; ai < 2; ++ai)
#pragma unroll
            for (int m = 0; m < 4; ++m) {
                const size_t row = (size_t)(u.pm * BM + ai * HALF + wr * 64 + m * 16 + fr);
                float s = 0.f;
#pragma unroll
                for (int bj = 0; bj < 2; ++bj) {
                    const f32x4 v0 = acc[ai][bj][m][0], v1 = acc[ai][bj][m][1];
                    float* yp = Y + row * 2048 + col0 + bj * HALF; *(f32x4*)yp = v0; *(f32x4*)(yp + 4) = v1;
                    s += (v0[0] * v0[0] + v0[1] * v0[1]) + (v0[2] * v0[2] + v0[3] * v0[3]) + (v1[0] * v1[0] + v1[1] * v1[1]) + (v1[2] * v1[2] + v1[3] * v1[3]);
                }
                s += __shfl_xor(s, 16); s += __shfl_xor(s, 32);
                if (fq == 0) SS[row * 32 + u.pn * 4 + wc] = s;
            }
    }
};
}

namespace att {
#define ALDS __attribute__((address_space(3)))
typedef unsigned short bf16_t;
typedef short bf16x8 __attribute__((ext_vector_type(8)));
typedef short s16x4 __attribute__((ext_vector_type(4)));
typedef short v4i16_t __attribute__((ext_vector_type(4)));
typedef float f32x16 __attribute__((ext_vector_type(16)));
typedef unsigned u32x4 __attribute__((ext_vector_type(4)));
constexpr int PITCH = 1024;
constexpr int L_K = 0, L_V = 32768, TILE_B = 16384;
constexpr int L_XCH = 0;
constexpr float THR = 6.0f;
__device__ __forceinline__ int crow(int r, int hi) { return (r & 3) + 8 * (r >> 2) + 4 * hi; }
__device__ __forceinline__ unsigned cvtpk(float lo, float hi) { unsigned r; asm volatile("v_cvt_pk_bf16_f32 %0, %1, %2" : "=v"(r) : "v"(lo), "v"(hi)); return r; }
__device__ __forceinline__ s16x4 vtr(const ALDS unsigned char* p) { return __builtin_bit_cast(s16x4, __builtin_amdgcn_ds_read_tr16_b64_v4i16((ALDS v4i16_t*)p)); }
__device__ __forceinline__ float bf2f(unsigned short b) { return __builtin_bit_cast(float, (unsigned)b << 16); }
__device__ __forceinline__ unsigned short f2bf(float f) { unsigned u = __builtin_bit_cast(unsigned, f); return (unsigned short)((u + 0x7fffu + ((u >> 16) & 1u)) >> 16); }
#define AMX3(a, b, c) __builtin_fmaxf(__builtin_fmaxf((a), (b)), (c))
__device__ __forceinline__ float rowmax(const f32x16& p0, const f32x16& p1) {
    float a = AMX3(p0[0], p0[1], p1[0]), b = AMX3(p0[2], p0[3], p1[1]); a = AMX3(a, p1[2], p1[3]);
#pragma unroll
    for (int r = 4; r < 16; r += 4) { a = AMX3(a, p0[r], p0[r + 1]); b = AMX3(b, p0[r + 2], p0[r + 3]); a = AMX3(a, p1[r], p1[r + 1]); b = AMX3(b, p1[r + 2], p1[r + 3]); }
    float m = __builtin_fmaxf(a, b); auto rr = __builtin_amdgcn_permlane32_swap(__float_as_uint(m), __float_as_uint(m), false, false);
    return __builtin_fmaxf(__uint_as_float(rr[0]), __uint_as_float(rr[1]));
}
struct TileRegs { u32x4 k0, k1, v0, v1; };
__device__ __forceinline__ void tile_issue(TileRegs& R, const unsigned char* Kt, const unsigned char* Vt, int tid) {
    const unsigned lo = (unsigned)((tid >> 4) * PITCH + (tid & 15) * 8) * 2u;
    R.k0 = *(const u32x4*)(Kt + lo); R.k1 = *(const u32x4*)(Kt + lo + 32 * PITCH * 2);
    R.v0 = *(const u32x4*)(Vt + lo); R.v1 = *(const u32x4*)(Vt + lo + 32 * PITCH * 2);
}
__device__ __forceinline__ void tile_commit(const TileRegs& R, ALDS unsigned char* kbuf, ALDS unsigned char* vbuf, int tid) {
    const int c = tid & 15, row = tid >> 4;
    const int ko = row * 256 + ((c ^ (row & 15)) << 4);
    *(ALDS u32x4*)(kbuf + ko) = R.k0; *(ALDS u32x4*)(kbuf + ko + 8192) = R.k1;
    const int vo = (c >> 2) * 4096 + (row >> 4) * 1024 + (row & 15) * 64 + (c & 3) * 16;
    *(ALDS u32x4*)(vbuf + vo) = R.v0; *(ALDS u32x4*)(vbuf + vo + 2048) = R.v1;
}
struct UnitP {
    unsigned qoff;
    unsigned koff, voff;
    unsigned zoff, ooff;
    int t_begin, t_end;
    int vis_lo, vis_hi;
    int mask_tile;
    int kpos0, qpos;
    const ALDS float* tab;
    int kc0;
    int out_row0;
    int hcol;
};
template <int KIND>
__device__ __forceinline__ void attn_unit(const UnitP& U, const unsigned char* ws, ALDS unsigned char* lds, ALDS float* wsf, float lam, const float* subg) {
    constexpr int ND0 = (KIND == 0) ? 4 : 8;
    const int tid = threadIdx.x, lane = tid & 63, r32 = lane & 31, hi = lane >> 5; const int wid = __builtin_amdgcn_readfirstlane(tid >> 6);
    const bool active = U.vis_lo <= U.vis_hi;
    TileRegs R;
    tile_issue(R, ws + U.koff + (size_t)U.t_begin * (64 * PITCH * 2), ws + U.voff + (size_t)U.t_begin * (64 * PITCH * 2), tid);
    bf16x8 qr[ND0];
#pragma unroll
    for (int d0 = 0; d0 < ND0; ++d0) qr[d0] = *(const bf16x8*)(ws + U.qoff + (unsigned)(r32 * PITCH + d0 * 16 + hi * 8) * 2u);
    f32x16 o[4];
#pragma unroll
    for (int d0 = 0; d0 < 4; ++d0) o[d0] = f32x16{};
    float mhat = 0.f, l_reg = 0.f;
    tile_commit(R, lds + L_K, lds + L_V, tid);
    __syncthreads();
    const int first_t = (U.vis_lo > U.t_begin) ? U.vis_lo : U.t_begin;
    const int vbo = ((lane >> 4) & 1) * 32 + (lane & 3) * 8 + (4 * hi + ((lane & 15) >> 2)) * 64;
    int cur = 0;
    for (int t = U.t_begin; t < U.t_end; ++t) {
        const bool more = (t + 1 < U.t_end);
        if (more) tile_issue(R, ws + U.koff + (size_t)(t + 1) * (64 * PITCH * 2), ws + U.voff + (size_t)(t + 1) * (64 * PITCH * 2), tid);
        if (t >= U.vis_lo && t <= U.vis_hi) {
            const ALDS unsigned char* kb = lds + L_K + cur * TILE_B + r32 * 256;
            const ALDS unsigned char* vb = lds + L_V + cur * TILE_B + vbo;
            const int relmax = U.kpos0 + 64 * t + 63 - U.qpos;
            const bool farb = (relmax <= -128);
            const float cinit = (farb ? U.tab[0] : 0.f) - mhat;
            f32x16 p0, p1;
#pragma unroll
            for (int r = 0; r < 16; ++r) { p0[r] = cinit; p1[r] = cinit; }
#pragma unroll
            for (int d0 = 0; d0 < ND0; ++d0) {
                const int off = (((U.kc0 + 2 * d0 + hi) ^ (r32 & 15)) << 4);
                const bf16x8 k0 = *(const ALDS bf16x8*)(kb + off), k1 = *(const ALDS bf16x8*)(kb + 8192 + off);
                p0 = __builtin_amdgcn_mfma_f32_32x32x16_bf16(k0, qr[d0], p0, 0, 0, 0);
                p1 = __builtin_amdgcn_mfma_f32_32x32x16_bf16(k1, qr[d0], p1, 0, 0, 0);
            }
            if (!farb) {
                const int base = U.kpos0 + 64 * t - (U.qpos + r32) + 4 * hi + 128;
#pragma unroll
                for (int r = 0; r < 16; ++r) {
                    int i0 = base + (r & 3) + 8 * (r >> 2); int i1 = i0 + 32;
                    i0 = i0 < 0 ? 0 : (i0 > 191 ? 191 : i0); i1 = i1 < 0 ? 0 : (i1 > 191 ? 191 : i1);
                    p0[r] += U.tab[i0]; p1[r] += U.tab[i1];
                }
            }
            if (t == U.mask_tile) {
#pragma unroll
                for (int r = 0; r < 16; ++r) p1[r] = -INFINITY;
            }
            const float rm = rowmax(p0, p1);
            const bool first = (t == first_t);
            if (first || __any(rm > THR)) {
                const float dl = first ? rm : __builtin_fmaxf(rm, 0.f);
                mhat += dl;
#pragma unroll
                for (int r = 0; r < 16; ++r) { p0[r] -= dl; p1[r] -= dl; }
                if (!first) {
                    const float f = __builtin_amdgcn_exp2f(-dl); l_reg *= f;
                    if (hi == 0) wsf[r32] = f;
                    asm volatile("s_waitcnt lgkmcnt(0)" ::: "memory");
#pragma unroll
                    for (int r = 0; r < 16; ++r) { const float fr_ = wsf[crow(r, hi)];
#pragma unroll
                        for (int d0 = 0; d0 < 4; ++d0) o[d0][r] *= fr_; }
                }
            }
            float sacc = 0.f;
#pragma unroll
            for (int r = 0; r < 16; ++r) { p0[r] = __builtin_amdgcn_exp2f(p0[r]); p1[r] = __builtin_amdgcn_exp2f(p1[r]); sacc += p0[r] + p1[r]; }
            l_reg += sacc;
            u32x4 pw[4];
#pragma unroll
            for (int i = 0; i < 4; ++i) { pw[0][i] = cvtpk(p0[2 * i], p0[2 * i + 1]); pw[1][i] = cvtpk(p0[8 + 2 * i], p0[8 + 2 * i + 1]); pw[2][i] = cvtpk(p1[2 * i], p1[2 * i + 1]); pw[3][i] = cvtpk(p1[8 + 2 * i], p1[8 + 2 * i + 1]); }
#pragma unroll
            for (int d0 = 0; d0 < 4; ++d0) {
#pragma unroll
                for (int ks = 0; ks < 4; ++ks) {
                    const s16x4 lo = vtr(vb + d0 * 4096 + ks * 1024), hh = vtr(vb + d0 * 4096 + ks * 1024 + 512);
                    const bf16x8 vf = (bf16x8){lo[0], lo[1], lo[2], lo[3], hh[0], hh[1], hh[2], hh[3]};
                    o[d0] = __builtin_amdgcn_mfma_f32_32x32x16_bf16(__builtin_bit_cast(bf16x8, pw[ks]), vf, o[d0], 0, 0, 0);
                }
            }
        }
        if (more) tile_commit(R, lds + L_K + (cur ^ 1) * TILE_B, lds + L_V + (cur ^ 1) * TILE_B, tid);
        __syncthreads();
        cur ^= 1;
    }
    { auto rr = __builtin_amdgcn_permlane32_swap(__float_as_uint(l_reg), __float_as_uint(l_reg), false, false); l_reg = __uint_as_float(rr[0]) + __uint_as_float(rr[1]); }
    if (hi == 0) wsf[32 + r32] = l_reg;
    asm volatile("s_waitcnt lgkmcnt(0)" ::: "memory");
    float rli[16];
#pragma unroll
    for (int r = 0; r < 16; ++r) rli[r] = __builtin_amdgcn_rcpf(wsf[32 + crow(r, hi)]);
    if (KIND == 0) {
        ALDS float* xch = (ALDS float*)(lds + L_XCH);
        if (wid >= 4 && active) {
#pragma unroll
            for (int d0 = 0; d0 < 4; ++d0)
#pragma unroll
                for (int r = 0; r < 16; ++r) xch[(((wid - 4) * 4 + d0) * 16 + r) * 64 + lane] = o[d0][r] * rli[r];
        }
        __syncthreads();
        if (wid < 4 && active) {
            float ss[16];
#pragma unroll
            for (int r = 0; r < 16; ++r) ss[r] = 0.f;
#pragma unroll
            for (int d0 = 0; d0 < 4; ++d0)
#pragma unroll
                for (int r = 0; r < 16; ++r) { const float x = o[d0][r] * rli[r] - lam * xch[((wid * 4 + d0) * 16 + r) * 64 + lane]; o[d0][r] = x; ss[r] += x * x; }
#pragma unroll
            for (int r = 0; r < 16; ++r) {
                float s = ss[r];
                s += __shfl_xor(s, 1); s += __shfl_xor(s, 2); s += __shfl_xor(s, 4); s += __shfl_xor(s, 8); s += __shfl_xor(s, 16);
                ss[r] = __builtin_amdgcn_rsqf(s * (1.0f / 128.0f) + 1e-6f) * 0.8f;
            }
#pragma unroll
            for (int d0 = 0; d0 < 4; ++d0) {
                const float sg = subg[32 * d0 + r32]; const int gcol = U.hcol + 32 * d0 + r32;
#pragma unroll
                for (int r = 0; r < 16; ++r) { const unsigned off = (unsigned)((U.out_row0 + crow(r, hi)) * PITCH + gcol) * 2u;
                    *(bf16_t*)(const_cast<unsigned char*>(ws) + U.ooff + off) = f2bf(o[d0][r] * ss[r] * sg * bf2f(*(const bf16_t*)(ws + U.zoff + off))); }
            }
        }
        __syncthreads();
    } else {
        if (active) {
#pragma unroll
            for (int d0 = 0; d0 < 4; ++d0) {
                const int gcol = U.hcol + 32 * d0 + r32;
#pragma unroll
                for (int r = 0; r < 16; ++r) { const unsigned off = (unsigned)((U.out_row0 + crow(r, hi)) * PITCH + gcol) * 2u;
                    *(bf16_t*)(const_cast<unsigned char*>(ws) + U.ooff + off) = f2bf(o[d0][r] * rli[r] * bf2f(*(const bf16_t*)(ws + U.zoff + off))); }
            }
        }
    }
}
}
#define GAS __attribute__((address_space(1)))
#define LAS __attribute__((address_space(3)))
typedef unsigned short bf16;
typedef unsigned v4u __attribute__((ext_vector_type(4)));
typedef float f32x4 __attribute__((ext_vector_type(4)));
typedef short bf16x8 __attribute__((ext_vector_type(8)));
typedef GAS unsigned gu32;
typedef GAS unsigned long long gu64;
#define RLX_AGENT __ATOMIC_RELAXED, __HIP_MEMORY_SCOPE_AGENT
#define LDS_WAIT() asm volatile("s_waitcnt lgkmcnt(0)" ::: "memory")
#define VM_WAIT() asm volatile("s_waitcnt vmcnt(0)" ::: "memory")
__device__ __forceinline__ unsigned long long rt() { return __builtin_amdgcn_s_memrealtime(); }
__device__ __forceinline__ unsigned f2bf(float f) { unsigned u = __builtin_bit_cast(unsigned, f); return (u + 0x7fffu + ((u >> 16) & 1u)) >> 16; }
__device__ __forceinline__ unsigned pk2(float lo, float hi) { return f2bf(lo) | (f2bf(hi) << 16); }
#define XB_TMO      128
#define XB_XCNT(j)  (256  + 64 * (j))
#define XB_XSUB(j)  (1280 + 64 * (j))
#define XB_XGEN(j)  (2304 + 64 * (j))
#define XB_TOP      3328
#define XB_TOPGEN   3392
#define XCD_BAR_WORDS 3456
#define XB_SPIN_CAP (1u << 18)

__device__ __forceinline__ unsigned xb_ld(unsigned* p)              { return __hip_atomic_load(p, __ATOMIC_RELAXED, __HIP_MEMORY_SCOPE_AGENT); }
__device__ __forceinline__ unsigned xb_add(unsigned* p, unsigned v) { return __hip_atomic_fetch_add(p, v, __ATOMIC_RELAXED, __HIP_MEMORY_SCOPE_AGENT); }
__device__ __forceinline__ unsigned xb_xcc_id() { return (unsigned)__builtin_amdgcn_s_getreg((3 << 11) | 20) & 0xFu; }
#define XB_SPIN(cond, bar) do { unsigned _sp = 0; while (cond) { __builtin_amdgcn_s_sleep(1); \
    if ((++_sp & 255u) == 0u) { if (xb_ld(&(bar)[XB_TMO])) break; if (_sp > XB_SPIN_CAP) { atomicAdd(&(bar)[XB_TMO], 1u); break; } } } } while (0)

struct XcdBarrier {
    unsigned* bar; unsigned x;
    volatile LAS unsigned* st;
};

__device__ __forceinline__ XcdBarrier xcd_barrier_post(unsigned* bar, volatile LAS unsigned* st) {
    XcdBarrier b; b.bar = bar; b.x = xb_xcc_id(); b.st = st;
    if (threadIdx.x == 0) (void)xb_add(&bar[XB_XCNT(b.x)], 1u);
    return b;
}
__device__ __forceinline__ void xcd_barrier_complete(unsigned* bar, unsigned x, unsigned& nloc, unsigned& nx) {
    const unsigned G = gridDim.x * gridDim.y * gridDim.z;
    unsigned sum, cnt, mine, sp = 0u;
    for (;;) {
        sum = 0u; cnt = 0u; mine = 0u;
#pragma unroll
        for (unsigned j = 0; j < 16; ++j) { const unsigned c = xb_ld(&bar[XB_XCNT(j)]); sum += c; cnt += (c > 0u) ? 1u : 0u; mine = (j == x) ? c : mine; }
        if (sum == G) break;
        __builtin_amdgcn_s_sleep(1);
        if ((++sp & 255u) == 0u) { if (xb_ld(&bar[XB_TMO])) break; if (sp > XB_SPIN_CAP) { atomicAdd(&bar[XB_TMO], 1u); break; } }
    }
    nloc = mine > 0u ? mine : 1u; nx = cnt > 0u ? cnt : 1u;
}

__device__ __forceinline__ void xcd_barrier(const XcdBarrier& b) {
    asm volatile("s_waitcnt vmcnt(0)" ::: "memory");
    __syncthreads();
    if (threadIdx.x == 0) {
        unsigned* bar = b.bar;
        __builtin_amdgcn_s_waitcnt(0);
        unsigned nloc = b.st[0], nx = b.st[1];
        if (nloc == 0u) { xcd_barrier_complete(bar, b.x, nloc, nx); b.st[0] = nloc; b.st[1] = nx; }
        const unsigned old = xb_add(&bar[XB_XSUB(b.x)], 1u);
        const unsigned gen = old / nloc;
        if (old + 1u == (gen + 1u) * nloc) {
            __builtin_amdgcn_fence(__ATOMIC_RELEASE, "agent");
            asm volatile("s_waitcnt vmcnt(0)" ::: "memory");
            const unsigned og = xb_add(&bar[XB_TOP], 1u);
            const unsigned tg = og / nx;
            if (og + 1u == (tg + 1u) * nx) xb_add(&bar[XB_TOPGEN], 1u);
            else XB_SPIN(xb_ld(&bar[XB_TOPGEN]) == tg, bar);
            __builtin_amdgcn_fence(__ATOMIC_ACQUIRE, "agent");
            xb_add(&bar[XB_XGEN(b.x)], 1u);
            asm volatile("s_waitcnt vmcnt(0)" ::: "memory");
        } else {
            XB_SPIN(xb_ld(&bar[XB_XGEN(b.x)]) == gen, bar);
            __builtin_amdgcn_fence(__ATOMIC_ACQUIRE, "agent");
            asm volatile("s_waitcnt vmcnt(0)" ::: "memory");
        }
    }
    __syncthreads();
}

struct Frame {
    LAS unsigned char* lds; volatile LAS unsigned* MISC; gu32* ctl;
    int tid, lane, wave, vcu, G;
};
__device__ __forceinline__ float wave_sum(float v) {
#pragma unroll
    for (int o = 1; o < 64; o <<= 1) v += __shfl_xor(v, o);
    return v;
}
__device__ __forceinline__ void p0_transpose_item(const float* W, int K, int N, bf16* WT, int row_off, LAS float* scr, int item, int lane) {
    const int nblk = N / 32, kb = item / nblk, nb = item % nblk, k0 = 64 * kb, n0 = 32 * nb;
#pragma unroll 8
    for (int i = 0; i < 32; ++i) { const int kk = 2 * i + (lane >> 5); scr[kk * 33 + (lane & 31)] = W[(size_t)(k0 + kk) * N + n0 + (lane & 31)]; }
    LDS_WAIT(); asm volatile("" ::: "memory");
    const int c = lane & 7;
#pragma unroll
    for (int j = 0; j < 4; ++j) { const int n = (lane >> 3) + 8 * j; const LAS float* s = scr + (8 * c) * 33 + n;
        v4u o; o.x = pk2(s[0 * 33], s[1 * 33]); o.y = pk2(s[2 * 33], s[3 * 33]); o.z = pk2(s[4 * 33], s[5 * 33]); o.w = pk2(s[6 * 33], s[7 * 33]);
        *(GAS v4u*)(WT + (size_t)(row_off + n0 + n) * K + k0 + 8 * c) = o; }
    LDS_WAIT(); asm volatile("" ::: "memory");
}
__device__ __forceinline__ void rms_row_to_bf16(const float* xrow, const float* g, bf16* orow, int lane) {
    const GAS f32x4* xr = (const GAS f32x4*)xrow + lane; const GAS f32x4* gr = (const GAS f32x4*)g + lane;
    f32x4 v[8]; float s = 0.f;
#pragma unroll
    for (int j = 0; j < 8; ++j) { v[j] = xr[64 * j]; s += (v[j].x * v[j].x + v[j].y * v[j].y) + (v[j].z * v[j].z + v[j].w * v[j].w); }
    const float rstd = 1.0f / sqrtf(wave_sum(s) * (1.f / 2048.f) + 1e-6f);
    GAS unsigned long long* o8 = (GAS unsigned long long*)orow + lane;
#pragma unroll
    for (int j = 0; j < 8; ++j) { const f32x4 gg = gr[64 * j];
        o8[64 * j] = (unsigned long long)pk2(v[j].x * rstd * gg.x, v[j].y * rstd * gg.y) | ((unsigned long long)pk2(v[j].z * rstd * gg.z, v[j].w * rstd * gg.w) << 32); }
}
__device__ __forceinline__ void cvt_row_1024(const float* src, bf16* dst, float* fcopy, int lane) {
    const GAS f32x4* xr = (const GAS f32x4*)src + lane; GAS unsigned long long* o8 = (GAS unsigned long long*)dst + lane;
#pragma unroll
    for (int j = 0; j < 4; ++j) { const f32x4 v = xr[64 * j];
        o8[64 * j] = (unsigned long long)pk2(v.x, v.y) | ((unsigned long long)pk2(v.z, v.w) << 32);
        if (fcopy) ((GAS f32x4*)fcopy + lane)[64 * j] = v; }
}
__device__ __forceinline__ void zero_row_1024(bf16* dst, int lane) {
    GAS unsigned long long* o8 = (GAS unsigned long long*)dst + lane;
#pragma unroll
    for (int j = 0; j < 4; ++j) o8[64 * j] = 0ull;
}

struct Args { const float* in[19]; float* out; unsigned char* ws; int pad0, pad1; };

__global__ void __launch_bounds__(NWAVES * 64, 2) fwd_kernel(Args args) {
    extern __shared__ __attribute__((aligned(16))) unsigned char lds[];
    Frame F;
    F.lds = (LAS unsigned char*)lds; F.MISC = (volatile LAS unsigned*)(F.lds + MISC_OFF);
    F.tid = threadIdx.x; F.lane = F.tid & 63; F.wave = __builtin_amdgcn_readfirstlane(F.tid >> 6);
    F.G = gridDim.x; { const int bx = blockIdx.x; F.vcu = (F.G % 8 == 0) ? (bx % 8) * (F.G / 8) + bx / 8 : bx; }
    unsigned char* ws = args.ws; float* out = args.out;
    F.ctl = (gu32*)(ws + WS_CTL);
    if (F.tid < 64) ((LAS unsigned*)(F.lds + MISC_OFF))[F.tid] = 0u;
    __syncthreads();
    XcdBarrier bar = xcd_barrier_post((unsigned*)(F.ctl + CW_BAR), F.MISC + 8);

    const int gw = F.vcu * NWAVES + F.wave, NGW = F.G * NWAVES;

    {
        const float* x_prompt = args.in[0]; const float* x_sample = args.in[1];
        const float* cache_k_a = args.in[2]; const float* cache_v_a = args.in[3]; const float* cache_k_b = args.in[4]; const float* cache_v_b = args.in[5];
        const float* pre_norm = args.in[7]; const float* w_in = args.in[9]; const float* w_o_a = args.in[16]; const float* w_o_b = args.in[17]; const float* w_out = args.in[18];
        bf16* WinT = (bf16*)(ws + WS_WINT); bf16* WoT = (bf16*)(ws + WS_WOT); bf16* WoutT = (bf16*)(ws + WS_WOUTT); bf16* XN = (bf16*)(ws + WS_XN);
        bf16 *KAs = (bf16*)(ws + WS_KAS), *VAs = (bf16*)(ws + WS_VAS), *KBs = (bf16*)(ws + WS_KBS), *VBs = (bf16*)(ws + WS_VBS);
        LAS float* scr = (LAS float*)(F.lds + RING_OFF + F.wave * 16384);
        constexpr int I_IN = (DM / 64) * (NIN / 32), I_OA = (1024 / 64) * (DM / 32), I_OUT = (DM / 64) * (DM / 32);
        constexpr int NITEMS = I_IN + 2 * I_OA + I_OUT;
        for (int it = gw; it < NITEMS; it += NGW) {
            int r = it;
            if (r < I_IN) { p0_transpose_item(w_in, DM, NIN, WinT, 0, scr, r, F.lane); continue; } r -= I_IN;
            if (r < I_OA) { p0_transpose_item(w_o_a, 1024, DM, WoT, 0, scr, r, F.lane); continue; } r -= I_OA;
            if (r < I_OA) { p0_transpose_item(w_o_b, 1024, DM, WoT, 2048, scr, r, F.lane); continue; } r -= I_OA;
            p0_transpose_item(w_out, DM, DM, WoutT, 0, scr, r, F.lane);
        }
        for (int m = gw; m < MT; m += NGW) rms_row_to_bf16(m < SEQ ? x_prompt + (size_t)m * DM : x_sample + (size_t)(m - SEQ) * DM, pre_norm, XN + (size_t)m * DM, F.lane);
        for (int m = gw; m < 2 * 8 * PAST; m += NGW) { const int which = m / (8 * PAST), rr = m % (8 * PAST), b = rr / PAST, r = rr % PAST;
            cvt_row_1024((which ? cache_v_a : cache_k_a) + (size_t)rr * 1024, (which ? VAs : KAs) + ((size_t)b * KAS_ROWS + r) * 1024, nullptr, F.lane); }
        for (int m = gw; m < 2 * 8 * 512; m += NGW) { const int which = m / (8 * 512), rr = m % (8 * 512), b = rr / 512, r = rr % 512;
            float* fc = (r >= 32) ? out + (which ? O_VBS : O_KBS) + ((size_t)b * 512 + (r - 32)) * 1024 : nullptr;
            cvt_row_1024((which ? cache_v_b : cache_k_b) + (size_t)rr * 1024, (which ? VBs : KBs) + ((size_t)b * KBS_ROWS + r) * 1024, fc, F.lane); }
        for (int m = gw; m < 4 * 8 * 32; m += NGW) { const int which = m / 256, rr = m % 256, b = rr / 32, r = rr % 32;
            bf16* d = which == 0 ? KAs + ((size_t)b * KAS_ROWS + PAST + 32 + r) * 1024 : which == 1 ? VAs + ((size_t)b * KAS_ROWS + PAST + 32 + r) * 1024
                    : which == 2 ? KBs + ((size_t)b * KBS_ROWS + 544 + r) * 1024 : VBs + ((size_t)b * KBS_ROWS + 544 + r) * 1024;
            zero_row_1024(d, F.lane); }
    }
    xcd_barrier(bar);

    {
        pg8::Gemm g{(const bf16*)(ws + WS_XN), (const bf16*)(ws + WS_WINT), MT, NIN, DM}; pg8::StaticOrder S; S.init(MT, NIN, F.G, (int)blockIdx.x);
        pg8::EpiInProj E{ws, out};
        pg8::gemm_phase<pg8::EpiInProj, pg8::StaticOrder, true, true>(F.lds + RING_OFF, g, S, E);
    }
    xcd_barrier(bar);

    {
        const float* t5_bias = args.in[6]; const float* lq1 = args.in[10]; const float* lk1 = args.in[11]; const float* lq2 = args.in[12]; const float* lk2 = args.in[13];
        const float* subln = args.in[14]; const float* rel_bias_b = args.in[15];
        LAS float* tab = (LAS float*)(F.lds + TAB_OFF);
        for (int i = F.tid; i < 8 * 192; i += NWAVES * 64) {
            const int h = i / 192, idx = i % 192, rel = idx - 128;
            const int n = rel < 0 ? -rel : rel; int bkt;
            if (n < 8) bkt = n; else { const int k = (31 - __builtin_clz((unsigned)(n * n))) - 6; bkt = 8 + k; if (bkt > 15) bkt = 15; }
            if (rel > 0) bkt += 16;
            tab[i] = t5_bias[bkt * 8 + h] * LOG2E;
            tab[8 * 192 + i] = rel_bias_b[h * 257 + idx] * LOG2E;
        }
        float s1 = lq1[F.lane] * lk1[F.lane], s2 = lq2[F.lane] * lk2[F.lane];
        s1 = wave_sum(s1); s2 = wave_sum(s2);
        const float lam = expf(s1) - expf(s2) + 0.2f;
        __syncthreads();
        LAS float* wsf = (LAS float*)(F.lds + WSF_OFF) + F.wave * 64;
        const int w = F.wave, g = w >> 2, j = w & 3;
        for (;;) {
            if (F.tid == 0) F.MISC[16] = __hip_atomic_fetch_add((unsigned*)(F.ctl + CW_QUEUE), 1u, __ATOMIC_RELAXED, __HIP_MEMORY_SCOPE_AGENT);
            __syncthreads();
            const int ui = (int)F.MISC[16];
            __syncthreads();
            if (ui >= 896) break;
            int kind, h, q;
            if (ui < 384) { kind = 0; q = 63 - ui / 8; h = ui % 8; }
            else if (ui < 448) { const int v = ui - 384; kind = 1; q = v / 8; h = v % 8; }
            else if (ui < 520) { const int v = ui - 448; kind = 0; q = 15 - v / 8; h = v % 8; }
            else if (ui < 776) { const int v = ui - 520; kind = 2; q = 31 - v / 8; h = v % 8; }
            else if (ui < 840) { const int v = ui - 776; kind = 3; q = v / 8; h = v % 8; }
            else { const int v = ui - 840; kind = 0; q = 6 - v / 8; h = v % 8; }
            att::UnitP U; U.hcol = h * 128; U.mask_tile = -1; U.kpos0 = 0; U.t_begin = 0;
            if (kind < 2) {
                const int row0 = (kind == 0) ? 128 * q + 32 * j : SEQ + 32 * q;
                U.qoff = (unsigned)WS_QA + (unsigned)(row0 * 1024 + h * 128 + g * 64) * 2u; U.qpos = (kind == 0) ? row0 : PAST; U.out_row0 = row0; U.tab = tab + h * 192; U.kc0 = 8 * g; U.vis_lo = 0;
                U.zoff = (unsigned)WS_ZA; U.ooff = (unsigned)WS_GATED;
                if (kind == 0) { U.koff = (unsigned)WS_KA + h * 256; U.voff = (unsigned)WS_VA + h * 256; U.t_end = 2 * q + 2; U.vis_hi = 2 * q + (j >> 1); }
                else { U.koff = (unsigned)WS_KAS + (unsigned)(q * KAS_ROWS * 1024 + h * 128) * 2u; U.voff = (unsigned)WS_VAS + (unsigned)(q * KAS_ROWS * 1024 + h * 128) * 2u; U.t_end = 33; U.vis_hi = (j == 0) ? 32 : -1; U.mask_tile = 32; }
                att::attn_unit<0>(U, ws, F.lds + RING_OFF, wsf, lam, subln);
            } else {
                const int row0 = (kind == 2) ? 256 * q + 32 * w : SEQ + 32 * q;
                U.qoff = (unsigned)WS_QB + (unsigned)(row0 * 1024 + h * 128) * 2u; U.qpos = (kind == 2) ? row0 : PAST; U.out_row0 = row0; U.tab = tab + (8 + h) * 192; U.kc0 = 0;
                U.zoff = (unsigned)WS_ZB; U.ooff = (unsigned)(WS_GATED + (size_t)MT * 1024 * 2);
                if (kind == 2) { const int cw = 4 * q + (w >> 1); U.koff = (unsigned)WS_KB + h * 256; U.voff = (unsigned)WS_VB + h * 256; U.t_begin = (4 * q - 8 > 0) ? 4 * q - 8 : 0; U.t_end = 4 * q + 4; U.vis_lo = cw - 8; U.vis_hi = cw; }
                else { U.koff = (unsigned)WS_KBS + (unsigned)(q * KBS_ROWS * 1024 + h * 128) * 2u; U.voff = (unsigned)WS_VBS + (unsigned)(q * KBS_ROWS * 1024 + h * 128) * 2u; U.t_end = 9; U.vis_lo = 0; U.vis_hi = (w == 0) ? 8 : -1; U.mask_tile = 8; U.kpos0 = PAST - 512; }
                att::attn_unit<1>(U, ws, F.lds + RING_OFF, wsf, lam, subln);
            }
        }
    }
    xcd_barrier(bar);

    {
        pg8::Gemm g{(const bf16*)(ws + WS_GATED), (const bf16*)(ws + WS_WOT), 2 * MT, 4096, 1024}; pg8::MergeOrder S{(int)blockIdx.x, F.G};
        pg8::EpiMerge E{(const bf16*)(ws + WS_GA), (const bf16*)(ws + WS_GB), (float*)(ws + WS_PART), (bf16*)(ws + WS_MM)};
        pg8::gemm_phase<pg8::EpiMerge, pg8::MergeOrder, true, true>(F.lds + RING_OFF, g, S, E);
    }
    xcd_barrier(bar);

    {
        pg8::Gemm g{(const bf16*)(ws + WS_MM), (const bf16*)(ws + WS_WOUTT), MT, DM, DM}; pg8::OutOrder S{(int)blockIdx.x, F.G};
        pg8::EpiOut E{out + O_Y, (float*)(ws + WS_SS)};
        pg8::gemm_phase<pg8::EpiOut, pg8::OutOrder, true, true>(F.lds + RING_OFF, g, S, E);
    }
    xcd_barrier(bar);

    for (int m = gw; m < MT; m += NGW) {
        const float* x_prompt = args.in[0]; const float* x_sample = args.in[1]; const float* post_norm = args.in[8]; const float* SS = (const float*)(ws + WS_SS);
        float s = SS[(size_t)m * 32 + (F.lane & 31)];
        s += __shfl_xor(s, 1); s += __shfl_xor(s, 2); s += __shfl_xor(s, 4); s += __shfl_xor(s, 8); s += __shfl_xor(s, 16);
        const float rstd = 1.0f / sqrtf(s * (1.f / 2048.f) + 1e-6f);
        const GAS f32x4* xr = (const GAS f32x4*)(m < SEQ ? x_prompt + (size_t)m * DM : x_sample + (size_t)(m - SEQ) * DM) + F.lane;
        const GAS f32x4* gr = (const GAS f32x4*)post_norm + F.lane;
        GAS f32x4* yr = (GAS f32x4*)(out + O_Y + (size_t)m * DM) + F.lane;
#pragma unroll
        for (int jj = 0; jj < 8; ++jj) { const f32x4 xv = xr[64 * jj], gv = gr[64 * jj], yv = yr[64 * jj]; yr[64 * jj] = xv + yv * rstd * gv; }
    }
}

extern "C" void kernel_launch(void* const* d_in, const int* in_sizes, int n_in, void* d_out, int out_size, void* d_ws, size_t ws_size, hipStream_t stream) {
    static int grid = 0;
    if (grid == 0) {
        if (n_in != 19 || out_size != 44040192 || ws_size < WS_END) { fprintf(stderr, "kernel_launch: unexpected problem (n_in %d, out %d, ws %zu)\n", n_in, out_size, ws_size); grid = -1; return; }
        int dev = 0, cus = 0, per_cu = 0;
        if (hipGetDevice(&dev) != hipSuccess || hipDeviceGetAttribute(&cus, hipDeviceAttributeMultiprocessorCount, dev) != hipSuccess) { grid = -1; return; }
        if (hipFuncSetAttribute((const void*)fwd_kernel, hipFuncAttributeMaxDynamicSharedMemorySize, LDS_BYTES) != hipSuccess) { fprintf(stderr, "kernel_launch: hipFuncSetAttribute failed\n"); grid = -1; return; }
        if (hipOccupancyMaxActiveBlocksPerMultiprocessor(&per_cu, (const void*)fwd_kernel, NWAVES * 64, LDS_BYTES) != hipSuccess || per_cu < 1) { fprintf(stderr, "kernel_launch: occupancy query says %d blocks per CU\n", per_cu); grid = -1; (void)hipGetLastError(); return; }
        (void)hipGetLastError();
        grid = cus;
    }
    if (grid < 0) return;
    (void)hipMemsetAsync((char*)d_ws + WS_CTL, 0, CTL_ZERO_BYTES, stream);
    Args a{};
    for (int i = 0; i < 19; ++i) a.in[i] = (const float*)d_in[i];
    a.out = (float*)d_out; a.ws = (unsigned char*)d_ws;
    hipLaunchKernelGGL(fwd_kernel, dim3(grid), dim3(NWAVES * 64), LDS_BYTES, stream, a);
}
```

```cpp
#include <hip/hip_runtime.h>
#include <hip/hip_bf16.h>
#include <cstdio>
#include <cstdint>
namespace pg8 {
#define PG8_LAS __attribute__((address_space(3)))
typedef unsigned short bf16_t;
typedef short bf16x8 __attribute__((ext_vector_type(8)));
typedef float f32x4 __attribute__((ext_vector_type(4)));
typedef unsigned u32x4 __attribute__((ext_vector_type(4)));
constexpr int BM = 256, BK = 64, HALF = 128, HTB = HALF * BK * 2  , STAGE_BYTES = 8 * HTB, NXCD = 8, WGM = 4;

__host__ __device__ __forceinline__ int lds_byte(int r, int c) { const int st = (r >> 4) * 2 + (c >> 5), rr = r & 15, cc = c & 31, ob = rr * 64 + cc * 2; return st * 1024 + (ob ^ (((ob >> 9) & 1) << 5)); }
__host__ __device__ __forceinline__ void stage_rc(int b, int& R, int& C) { const int st = b / 1024, sb = b % 1024, swz = sb ^ (((sb >> 9) & 1) << 5); R = (st >> 1) * 16 + swz / 64; C = (st & 1) * 32 + (swz % 64) / 2; }
__host__ __device__ __forceinline__ int perm32(int rho) { const int n = rho >> 4, i = rho & 15; return 8 * (i >> 2) + 4 * n + (i & 3); }

struct Unit { int pm, pn; };
struct Gemm { const bf16_t* A; const bf16_t* Bt; int M, N, K; };

struct StaticOrder {
    int nM, nN, nwg, G, c;
    __host__ __device__ void init(int M, int N, int G_, int c_) { nM = M / BM; nN = N / BM; nwg = nM * nN; G = G_; c = c_; }
    __host__ __device__ bool next(int i, Unit& u) const {
        const long L = (long)i * G + c; if (L >= nwg) return false;
        int wgid = (int)L; { const int q = nwg / NXCD, r = nwg % NXCD, xcd = wgid % NXCD, off = wgid / NXCD; wgid = (xcd < r ? xcd * (q + 1) : r * (q + 1) + (xcd - r) * q) + off; }
        const int nig = WGM * nN, gid = wgid / nig, fm = gid * WGM, gsz = (nM - fm) < WGM ? (nM - fm) : WGM;
        u.pm = fm + ((wgid % nig) % gsz); u.pn = (wgid % nig) / gsz; return true;
    }
    __device__ __forceinline__ void a_ready(const Unit&) const {}
    __device__ __forceinline__ void done(const Unit&) const {}
};

__device__ __forceinline__ unsigned cvt_pk_bf16(float lo, float hi) { unsigned r; asm volatile("v_cvt_pk_bf16_f32 %0, %1, %2" : "=v"(r) : "v"(lo), "v"(hi)); return r; }
typedef float f32x2 __attribute__((ext_vector_type(2)));
template <class Epi, class Sched, bool ALIGN_EPI = false, bool SP2 = false>
__device__ __forceinline__ void gemm_phase(PG8_LAS unsigned char* lds, const Gemm g, const Sched& S, const Epi& E) {
    int tid_ = threadIdx.x; asm volatile("" : "+v"(tid_));
    const int tid = tid_, wid = __builtin_amdgcn_readfirstlane(tid >> 6), lane = tid & 63, wr = wid >> 2, wc = wid & 3, fr = lane & 15, fq = lane >> 4;
    const int K = g.K, nt = K / BK;
    unsigned voffA[2], voffB[2];
#pragma unroll
    for (int i = 0; i < 2; ++i) { int R, C; stage_rc(tid * 16 + i * 8192, R, C); const int Rb = Epi::PERM ? ((R & ~31) + perm32(R & 31)) : R;
        voffA[i] = (unsigned)(R * K + C) * 2u; voffB[i] = (unsigned)(Rb * K + C) * 2u; }
    const size_t kstep = (size_t)(BK * 2);
    const size_t hstep = (size_t)HALF * K * 2;
    const size_t tstep = 2 * hstep;
    const unsigned ldsw = (unsigned)wid * 1024u;
    const int aoff = lds_byte(wr * 64 + fr, fq * 8), boff = lds_byte(wc * 32 + fr, fq * 8);
#define PG8_SA(b, h) (((b) * 2 + (h)) * HTB)
#define PG8_SB(b, h) ((4 + (b) * 2 + (h)) * HTB)
#define PG8_STAGE(bufoff, gbase, voff) do { _Pragma("unroll") for (int _i = 0; _i < 2; ++_i) \
        __builtin_amdgcn_global_load_lds((const unsigned*)((const char*)(gbase) + (voff)[_i]), (PG8_LAS unsigned*)(lds + (bufoff) + ldsw + _i * 8192), 16, 0, 0); } while (0)
#define PG8_LDA(dst, b, h) do { _Pragma("unroll") for (int m = 0; m < 4; ++m) _Pragma("unroll") for (int k = 0; k < 2; ++k) dst[m][k] = *(const PG8_LAS bf16x8*)(lds + PG8_SA(b, h) + aoff + m * 2048 + k * 1024); } while (0)
#define PG8_LDB(dst, b, h) do { _Pragma("unroll") for (int n = 0; n < 2; ++n) _Pragma("unroll") for (int k = 0; k < 2; ++k) dst[n][k] = *(const PG8_LAS bf16x8*)(lds + PG8_SB(b, h) + boff + n * 2048 + k * 1024); } while (0)
#define PG8_MMA(ai, bj, At, Bt) do { __builtin_amdgcn_s_setprio(1); _Pragma("unroll") for (int m = 0; m < 4; ++m) _Pragma("unroll") for (int n = 0; n < 2; ++n) _Pragma("unroll") for (int k = 0; k < 2; ++k) \
        acc[ai][bj][m][n] = __builtin_amdgcn_mfma_f32_16x16x32_bf16(Bt[n][k], At[m][k], acc[ai][bj][m][n], 0, 0, 0); __builtin_amdgcn_s_setprio(0); } while (0)
#define PG8_WAIT_V(n) asm volatile("s_waitcnt vmcnt(" #n ")" ::: "memory")
#define PG8_WAIT_L(n) asm volatile("s_waitcnt lgkmcnt(" #n ")" ::: "memory")
#define PG8_BAR __builtin_amdgcn_s_barrier()
#define PG8_SCHED __builtin_amdgcn_sched_barrier(0)
    Unit cur, nxt; int ui = 0;
    if (!S.next(0, cur)) return;
    f32x4 acc[2][2][4][2];
#pragma unroll
    for (int a = 0; a < 2; ++a)
#pragma unroll
        for (int b = 0; b < 2; ++b)
#pragma unroll
            for (int m = 0; m < 4; ++m)
#pragma unroll
                for (int n = 0; n < 2; ++n) acc[a][b][m][n] = (f32x4){0.f, 0.f, 0.f, 0.f};
    bf16x8 At[4][2], B0[2][2], B1[2][2];
    const char* cA = (const char*)g.A + (size_t)cur.pm * tstep; const char* cB = (const char*)g.Bt + (size_t)cur.pn * tstep;
    S.a_ready(cur);
    if constexpr (SP2) {
        PG8_STAGE(PG8_SB(0, 0), cB, voffB); PG8_STAGE(PG8_SB(0, 1), cB + hstep, voffB); PG8_STAGE(PG8_SA(0, 0), cA, voffA); PG8_STAGE(PG8_SA(0, 1), cA + hstep, voffA);
        if (wr == 1) PG8_BAR;
        PG8_WAIT_V(2); PG8_BAR;
        PG8_STAGE(PG8_SB(1, 0), cB + kstep, voffB); PG8_STAGE(PG8_SA(1, 0), cA + kstep, voffA); PG8_STAGE(PG8_SB(1, 1), cB + hstep + kstep, voffB);
        PG8_WAIT_V(6); PG8_BAR;
    } else {
        PG8_STAGE(PG8_SB(0, 0), cB, voffB); PG8_STAGE(PG8_SA(0, 0), cA, voffA); PG8_STAGE(PG8_SB(0, 1), cB + hstep, voffB); PG8_STAGE(PG8_SA(0, 1), cA + hstep, voffA);
        if (wr == 1) PG8_BAR;
        PG8_WAIT_V(4); PG8_BAR;
        PG8_STAGE(PG8_SB(1, 0), cB + kstep, voffB); PG8_STAGE(PG8_SA(1, 0), cA + kstep, voffA); PG8_STAGE(PG8_SB(1, 1), cB + hstep + kstep, voffB);
        PG8_WAIT_V(6); PG8_BAR;
    }
    for (;;) {
        const bool has_next = S.next(ui + 1, nxt);
        const char* nA = has_next ? (const char*)g.A + (size_t)nxt.pm * tstep : cA; const char* nB = has_next ? (const char*)g.Bt + (size_t)nxt.pn * tstep : cB;
        for (int t = 0; t < nt; t += 2) {
            const bool last = (t == nt - 2);
            const char* a1 = cA + (size_t)(t + 1) * kstep;
            const char* a2 = last ? nA : cA + (size_t)(t + 2) * kstep; const char* b2 = last ? nB : cB + (size_t)(t + 2) * kstep;
            const char* a3 = a2 + kstep; const char* b3 = b2 + kstep;
            if (last && has_next) S.a_ready(nxt);
            if constexpr (SP2) {
            PG8_LDB(B0, 0, 0); PG8_LDB(B1, 0, 1); PG8_SCHED; PG8_LDA(At, 0, 0); PG8_STAGE(PG8_SA(1, 1), a1 + hstep, voffA);
            PG8_WAIT_V(8); PG8_WAIT_L(0); PG8_BAR; PG8_MMA(0, 0, At, B0); PG8_MMA(0, 1, At, B1); PG8_BAR; PG8_SCHED;
            PG8_LDA(At, 0, 1); PG8_STAGE(PG8_SB(0, 0), b2, voffB); PG8_STAGE(PG8_SB(0, 1), b2 + hstep, voffB); PG8_STAGE(PG8_SA(0, 0), a2, voffA);
            PG8_WAIT_V(8); PG8_WAIT_L(0); PG8_BAR; PG8_MMA(1, 0, At, B0); PG8_MMA(1, 1, At, B1); PG8_BAR; PG8_SCHED;
            PG8_LDB(B0, 1, 0); PG8_LDB(B1, 1, 1); PG8_SCHED; PG8_LDA(At, 1, 0); PG8_STAGE(PG8_SA(0, 1), a2 + hstep, voffA);
            PG8_WAIT_V(8); PG8_WAIT_L(0); PG8_BAR; PG8_MMA(0, 0, At, B0); PG8_MMA(0, 1, At, B1); PG8_BAR; PG8_SCHED;
            PG8_LDA(At, 1, 1); PG8_STAGE(PG8_SB(1, 0), b3, voffB); PG8_STAGE(PG8_SB(1, 1), b3 + hstep, voffB); PG8_STAGE(PG8_SA(1, 0), a3, voffA);
            PG8_WAIT_V(8); PG8_WAIT_L(0); PG8_BAR; PG8_MMA(1, 0, At, B0); PG8_MMA(1, 1, At, B1); PG8_BAR; PG8_SCHED;
            } else {
            PG8_LDB(B0, 0, 0); PG8_SCHED; PG8_LDA(At, 0, 0); PG8_STAGE(PG8_SA(1, 1), a1 + hstep, voffA);
            PG8_WAIT_L(8); PG8_BAR; PG8_WAIT_L(0); PG8_MMA(0, 0, At, B0); PG8_BAR; PG8_SCHED;
            PG8_LDB(B1, 0, 1); PG8_STAGE(PG8_SB(0, 0), b2, voffB);
            PG8_BAR; PG8_WAIT_L(0); PG8_MMA(0, 1, At, B1); PG8_BAR;
            PG8_LDA(At, 0, 1); PG8_STAGE(PG8_SA(0, 0), a2, voffA);
            PG8_BAR; PG8_WAIT_L(0); PG8_MMA(1, 0, At, B0); PG8_BAR; PG8_SCHED;
            PG8_STAGE(PG8_SB(0, 1), b2 + hstep, voffB);
            PG8_WAIT_V(6); PG8_BAR; PG8_MMA(1, 1, At, B1); PG8_BAR;
            PG8_LDB(B0, 1, 0); PG8_SCHED; PG8_LDA(At, 1, 0); PG8_STAGE(PG8_SA(0, 1), a2 + hstep, voffA);
            PG8_WAIT_L(8); PG8_BAR; PG8_WAIT_L(0); PG8_MMA(0, 0, At, B0); PG8_BAR; PG8_SCHED;
            PG8_LDB(B1, 1, 1); PG8_STAGE(PG8_SB(1, 0), b3, voffB);
            PG8_BAR; PG8_WAIT_L(0); PG8_MMA(0, 1, At, B1); PG8_BAR;
            PG8_LDA(At, 1, 1); PG8_STAGE(PG8_SA(1, 0), a3, voffA);
            PG8_BAR; PG8_WAIT_L(0); PG8_MMA(1, 0, At, B0); PG8_BAR; PG8_SCHED;
            PG8_STAGE(PG8_SB(1, 1), b3 + hstep, voffB);
            PG8_WAIT_V(6); PG8_BAR; PG8_MMA(1, 1, At, B1); PG8_BAR;
            }
        }
        if constexpr (ALIGN_EPI) { if (wr == 0) PG8_BAR; }
        if constexpr (!Epi::AFTER_DRAIN) { E(acc, cur, wr, wc, fr, fq); S.done(cur); }
        if (!has_next) break;
#pragma unroll
        for (int a = 0; a < 2; ++a)
#pragma unroll
            for (int b = 0; b < 2; ++b)
#pragma unroll
                for (int m = 0; m < 4; ++m)
#pragma unroll
                    for (int n = 0; n < 2; ++n) acc[a][b][m][n] = (f32x4){0.f, 0.f, 0.f, 0.f};
        cur = nxt; cA = nA; cB = nB; ++ui;
        if constexpr (ALIGN_EPI) { if (wr == 1) PG8_BAR; }
    }
    PG8_WAIT_V(0);
    if constexpr (!ALIGN_EPI) { if (wr == 0) PG8_BAR; }
    PG8_BAR;
    if constexpr (Epi::AFTER_DRAIN) { E.fused(acc, cur, wr, wc, fr, fq, lds, wid, lane); S.done(cur); }
#undef PG8_SA
#undef PG8_SB
#undef PG8_STAGE
#undef PG8_LDA
#undef PG8_LDB
#undef PG8_MMA
#undef PG8_WAIT_V
#undef PG8_WAIT_L
#undef PG8_BAR
#undef PG8_SCHED
}
}

constexpr int DM = 2048, SEQ = 8192, NSMP = 256, MT = SEQ + NSMP  , NIN = 12288;
constexpr int PAST = 2048, KAS_ROWS = 2112  , KBS_ROWS = 576  ;
constexpr float LOG2E = 1.4426950408889634f;
constexpr float QSCALE_A = 0.125f * LOG2E;
constexpr float QSCALE_B = 0.08838834764831845f * LOG2E;
constexpr size_t O_Y = 0, O_KAP = 17301504, O_VAP = 25690112, O_KBP = 34078720, O_VBP = 34603008, O_KAS = 35127296, O_VAS = 35389440, O_KBS = 35651584, O_VBS = 39845888;


#ifndef REP_P0
#define REP_P0 1
#endif
#ifndef REP_P3
#define REP_P3 1
#endif
#ifndef REP_P4
#define REP_P4 1
#endif
#ifndef REP_SW
#define REP_SW 1
#endif
#ifndef ATT_NQ8
#define ATT_NQ8 0
#endif
#ifndef PROBE_MULT
#define PROBE_MULT 0
#define PROBE_A 0
#define PROBE_B 1
#endif
#ifndef REP_P1
#define REP_P1 1
#endif
#ifndef REP_P2
#define REP_P2 1
#endif
constexpr int NWAVES = 8;
constexpr size_t MiB = 1u << 20;
constexpr size_t WS_CTL = 0, CTL_ZERO_BYTES = 65536;
constexpr size_t WS_SS = 382 * MiB;
constexpr size_t WS_MMS = 66 * MiB;
constexpr size_t WS_WOT = 2 * MiB;
constexpr size_t WS_WOUTT = 10 * MiB;
constexpr size_t WS_WINT = 18 * MiB;
constexpr size_t WS_XN = 66 * MiB;
constexpr size_t WS_GATED = 18 * MiB;
constexpr size_t WS_Y = 99 * MiB;
constexpr size_t SZ_R = (size_t)MT * 1024 * 2;
constexpr size_t WS_QA = WS_Y, WS_KA = WS_QA + SZ_R, WS_VA = WS_KA + SZ_R, WS_ZA = WS_VA + SZ_R, WS_QB = WS_ZA + SZ_R, WS_KB = WS_QB + SZ_R, WS_VB = WS_KB + SZ_R, WS_ZB = WS_VB + SZ_R;
constexpr size_t WS_GA = WS_ZB + SZ_R, WS_GB = WS_GA + 2 * SZ_R, WS_YEND = WS_GB + 2 * SZ_R;
constexpr size_t WS_MM = WS_Y;
constexpr size_t WS_KAS = 298 * MiB;
constexpr size_t SZ_KAS = (size_t)8 * KAS_ROWS * 1024 * 2, SZ_KBS = (size_t)8 * KBS_ROWS * 1024 * 2;
constexpr size_t WS_VAS = WS_KAS + SZ_KAS, WS_KBS = WS_VAS + SZ_KAS, WS_VBS = WS_KBS + SZ_KBS, WS_DEND = WS_VBS + SZ_KBS;
constexpr size_t WS_PART = WS_KAS;
constexpr size_t WS_END = 384 * MiB;
static_assert(WS_SS + (size_t)MT * 32 * 4 <= WS_END && WS_DEND <= WS_SS && WS_YEND <= WS_KAS && WS_DEND <= WS_END && WS_PART + (size_t)MT * 2048 * 4 <= WS_END && WS_XN + (size_t)MT * 2048 * 2 <= WS_Y && WS_GATED + (size_t)2 * MT * 1024 * 2 <= WS_XN, "d_ws map");
constexpr int CW_QUEUE = 64;
constexpr int CW_DONE_S = 1024, CW_DONE_M3 = 1088, CW_TMO = 32, CW_PANEL = 8192;
constexpr int CW_SIDE = 1152, SIDE_BATCH = 8;
constexpr int CW_BAR = 4096;
constexpr int RING_OFF = 0, RING_BYTES = 131072;
constexpr int MISC_OFF = RING_BYTES;
constexpr int TAB_OFF = RING_BYTES + 256;
constexpr int WSF_OFF = TAB_OFF + 2 * 8 * 192 * 4;
constexpr int LDS_BYTES = 147456;
static_assert(WSF_OFF + 8 * 64 * 4 <= LDS_BYTES, "LDS map");

namespace pg8 {
__device__ __forceinline__ float fast_sigmoid(float v) { return __builtin_amdgcn_rcpf(1.0f + __builtin_amdgcn_exp2f(-v * 1.4426950408889634f)); }
__device__ __forceinline__ float bf2f(unsigned short b) { return __builtin_bit_cast(float, (unsigned)b << 16); }

struct EpiInProj {
    static constexpr bool PERM = true, AFTER_DRAIN = false;
    unsigned char* ws; float* out;
    __device__ __forceinline__ void operator()(const f32x4 (&acc)[2][2][4][2], const Unit& u, int wr, int wc, int fr, int fq) const {
        const int pn = u.pn, T = pn >> 2; const bool smp = (u.pm == 32);
        size_t bbase; int bpitch = 1024, act = 0; float scale = 1.f; size_t fbase = 0; int lc0;
        int brow0 = u.pm * BM + wr * 64 + fr, bSA = 128, bSM = 32;
        int fmode = 0, frow0 = 0, fSA = 128, fSM = 32;
        if (T < 8) {
            lc0 = (pn & 3) * 256 + wc * 32 + 8 * fq;
            bbase = WS_QA + (size_t)T * SZ_R;
            if (T == 0) scale = QSCALE_A; else if (T == 4) scale = QSCALE_B; else if (T == 3 || T == 7) act = 1;
            else if (T == 1 || T == 2) {
                fmode = 1; frow0 = (smp ? 0 : u.pm * BM) + wr * 64 + fr; fbase = (T == 1) ? (smp ? O_KAS : O_KAP) : (smp ? O_VAS : O_VAP);
                if (smp) { bbase = (T == 1) ? WS_KAS : WS_VAS; brow0 = wr * 2 * KAS_ROWS + PAST + fr; bSA = 4 * KAS_ROWS; bSM = KAS_ROWS; }
            } else {
                if (smp) { fmode = 1; frow0 = wr * 2 * 512 + 480 + fr; fSA = 4 * 512; fSM = 512; fbase = (T == 5) ? O_KBS : O_VBS;
                           bbase = (T == 5) ? WS_KBS : WS_VBS; brow0 = wr * 2 * KBS_ROWS + 512 + fr; bSA = 4 * KBS_ROWS; bSM = KBS_ROWS; }
                else if (u.pm >= 30) { fmode = 1; frow0 = u.pm * BM - 7680 + wr * 64 + fr; fbase = (T == 5) ? O_KBP : O_VBP; }
            }
        } else { bpitch = 2048; act = 2; if (pn < 40) { bbase = WS_GA; lc0 = (pn - 32) * 256 + wc * 32 + 8 * fq; } else { bbase = WS_GB; lc0 = (pn - 40) * 256 + wc * 32 + 8 * fq; } }
        bf16_t* const bdst = (bf16_t*)(ws + bbase); float* const fdst = out + fbase;
        const unsigned boff0 = (unsigned)brow0 * (unsigned)bpitch + (unsigned)lc0, bSAo = (unsigned)bSA * (unsigned)bpitch, bSMo = (unsigned)bSM * (unsigned)bpitch, b16 = 16u * (unsigned)bpitch;
        const unsigned foff0 = (unsigned)frow0 * 1024u + (unsigned)lc0, fSAo = (unsigned)fSA * 1024u, fSMo = (unsigned)fSM * 1024u;
#pragma unroll
        for (int ai = 0; ai < 2; ++ai)
#pragma unroll
            for (int m = 0; m < 4; ++m) {
                const unsigned boff = boff0 + ai * bSAo + (m >> 1) * bSMo + (m & 1) * b16;
                const unsigned foff = foff0 + ai * fSAo + (m >> 1) * fSMo + (m & 1) * 16384u;
#pragma unroll
                for (int bj = 0; bj < 2; ++bj) {
                    f32x4 v0 = acc[ai][bj][m][0], v1 = acc[ai][bj][m][1];
                    if (fmode != 0) { float* fp = fdst + (foff + bj * HALF); *(f32x4*)fp = v0; *(f32x4*)(fp + 4) = v1; }
                    if (act == 0) { v0 = v0 * scale; v1 = v1 * scale; }
                    else {
#pragma unroll
                        for (int e = 0; e < 4; ++e) { const float s0 = fast_sigmoid(v0[e]), s1 = fast_sigmoid(v1[e]); v0[e] = (act == 1) ? v0[e] * s0 : s0; v1[e] = (act == 1) ? v1[e] * s1 : s1; }
                    }
                    u32x4 w; w.x = cvt_pk_bf16(v0[0], v0[1]); w.y = cvt_pk_bf16(v0[2], v0[3]); w.z = cvt_pk_bf16(v1[0], v1[1]); w.w = cvt_pk_bf16(v1[2], v1[3]);
                    *(u32x4*)(bdst + (boff + bj * HALF)) = w;
                }
                asm volatile("" ::: "memory");
            }
    }
};

struct EpiMerge {
    static constexpr bool PERM = true, AFTER_DRAIN = false;
    unsigned char* ws; size_t mm_off;
    __device__ __forceinline__ void operator()(const f32x4 (&acc)[2][2][4][2], const Unit& u, int wr, int wc, int fr, int fq) const {
        const int part = (u.pm >= 33) ? 1 : 0, pm = u.pm - 33 * part, pn = u.pn - 8 * part;
#if PROBE_MULT
        if (blockIdx.x == 0 && threadIdx.x == 0 && mm_off == WS_MM) { const unsigned long long t_ = wall_clock64(); unsigned* c_ = (unsigned*)(ws + WS_CTL); c_[2048 + 2 * (7 + 2 * part)] = (unsigned)t_; c_[2048 + 2 * (7 + 2 * part) + 1] = (unsigned)(t_ >> 32); }
#endif
        const bf16_t* G = (const bf16_t*)(ws + (part ? WS_GB : WS_GA)); bf16_t* const PART = (bf16_t*)(ws + WS_PART); bf16_t* const Od = (bf16_t*)(ws + (part ? mm_off : WS_PART));
        const int col0 = pn * BM + wc * 32 + 8 * fq;
#pragma unroll
        for (int ai = 0; ai < 2; ++ai) {
          u32x4 gwv[4][2], pwv[4][2];
#pragma unroll
          for (int m = 0; m < 4; ++m)
#pragma unroll
            for (int bj = 0; bj < 2; ++bj) gwv[m][bj] = *(const u32x4*)(G + ((size_t)(pm * BM + ai * HALF + wr * 64 + m * 16 + fr) * 2048 + col0 + bj * HALF));
          if (part == 1) {
#pragma unroll
            for (int m = 0; m < 4; ++m)
#pragma unroll
              for (int bj = 0; bj < 2; ++bj) pwv[m][bj] = *(const u32x4*)(PART + ((size_t)(pm * BM + ai * HALF + wr * 64 + m * 16 + fr) * 2048 + col0 + bj * HALF));
          } else {
#pragma unroll
            for (int m = 0; m < 4; ++m)
#pragma unroll
              for (int bj = 0; bj < 2; ++bj) pwv[m][bj] = u32x4{0u, 0u, 0u, 0u};
          }
          asm volatile("" ::: "memory");
#pragma unroll
            for (int m = 0; m < 4; ++m) {
                const size_t row = (size_t)(pm * BM + ai * HALF + wr * 64 + m * 16 + fr);
#pragma unroll
                for (int bj = 0; bj < 2; ++bj) {
                    const size_t off = row * 2048 + col0 + bj * HALF;
                    const u32x4 gw = gwv[m][bj];
                    f32x4 g0, g1;
                    g0[0] = __builtin_bit_cast(float, gw.x << 16); g0[1] = __builtin_bit_cast(float, gw.x & 0xffff0000u); g0[2] = __builtin_bit_cast(float, gw.y << 16); g0[3] = __builtin_bit_cast(float, gw.y & 0xffff0000u);
                    g1[0] = __builtin_bit_cast(float, gw.z << 16); g1[1] = __builtin_bit_cast(float, gw.z & 0xffff0000u); g1[2] = __builtin_bit_cast(float, gw.w << 16); g1[3] = __builtin_bit_cast(float, gw.w & 0xffff0000u);
                    f32x4 v0 = acc[ai][bj][m][0] * g0, v1 = acc[ai][bj][m][1] * g1;
                    {
                        const u32x4 pw = pwv[m][bj];
                        v0[0] += __builtin_bit_cast(float, pw.x << 16); v0[1] += __builtin_bit_cast(float, pw.x & 0xffff0000u); v0[2] += __builtin_bit_cast(float, pw.y << 16); v0[3] += __builtin_bit_cast(float, pw.y & 0xffff0000u);
                        v1[0] += __builtin_bit_cast(float, pw.z << 16); v1[1] += __builtin_bit_cast(float, pw.z & 0xffff0000u); v1[2] += __builtin_bit_cast(float, pw.w << 16); v1[3] += __builtin_bit_cast(float, pw.w & 0xffff0000u);
                    }
                    u32x4 w; w.x = cvt_pk_bf16(v0[0], v0[1]); w.y = cvt_pk_bf16(v0[2], v0[3]); w.z = cvt_pk_bf16(v1[0], v1[1]); w.w = cvt_pk_bf16(v1[2], v1[3]);
                    *(u32x4*)(Od + off) = w;
                }
            }
        }
#if PROBE_MULT
        if (blockIdx.x == 0 && threadIdx.x == 0 && mm_off == WS_MM) { asm volatile("s_waitcnt vmcnt(0)" ::: "memory"); const unsigned long long t_ = wall_clock64(); unsigned* c_ = (unsigned*)(ws + WS_CTL); c_[2048 + 2 * (8 + 2 * part)] = (unsigned)t_; c_[2048 + 2 * (8 + 2 * part) + 1] = (unsigned)(t_ >> 32); }
#endif
    }
};
struct MergeOrder {
    int c, G;
    __device__ __forceinline__ bool next(int i, Unit& u) const {
        const int ti = i >> 1, part = i & 1; const int L = ti * G + c;
        if (L >= 256) return false;
        u.pm = L / 8 + 33 * part; u.pn = L % 8 + 8 * part; return true;
    }
    __device__ __forceinline__ void a_ready(const Unit&) const {}
    __device__ __forceinline__ void done(const Unit&) const {}
};
struct MergeOne {
    int pn, n;
    __device__ __forceinline__ bool next(int i, Unit& u) const { if (i >= n) return false; u.pm = 32 + 33 * i; u.pn = pn + 8 * i; return true; }
    __device__ __forceinline__ void a_ready(const Unit&) const {}
    __device__ __forceinline__ void done(const Unit&) const {}
};
struct OutOne {
    int pn, n;
    __device__ __forceinline__ bool next(int i, Unit& u) const { if (i >= n) return false; u.pm = 0; u.pn = pn; return true; }
    __device__ __forceinline__ void a_ready(const Unit&) const {}
    __device__ __forceinline__ void done(const Unit&) const {}
};
struct OutOrder {
    int c, G;
    __device__ __forceinline__ bool next(int i, Unit& u) const {
        const int L = i * G + c;
        if (L >= 256) return false;
        u.pm = L / 8; u.pn = L % 8; return true;
    }
    __device__ __forceinline__ void a_ready(const Unit&) const {}
    __device__ __forceinline__ void done(const Unit&) const {}
};
struct EpiOutNorm {
    static constexpr bool PERM = true, AFTER_DRAIN = true;
    const float* X; float* Y; const float* G;
    float* SS;
    unsigned* cnt; unsigned* tmo;
    __device__ __forceinline__ void fused(f32x4 (&acc)[2][2][4][2], const Unit& u, int wr, int wc, int fr, int fq, PG8_LAS unsigned char* lds, int wid, int lane) const {
        const int col0 = u.pn * BM + wc * 32 + 8 * fq;
#pragma unroll
        for (int ai = 0; ai < 2; ++ai)
#pragma unroll
            for (int m = 0; m < 4; ++m) {
                const size_t row = (size_t)(u.pm * BM + ai * HALF + wr * 64 + m * 16 + fr);
                float s = 0.f;
#pragma unroll
                for (int bj = 0; bj < 2; ++bj) {
                    const f32x4 v0 = acc[ai][bj][m][0], v1 = acc[ai][bj][m][1];
                    s += (v0[0] * v0[0] + v0[1] * v0[1]) + (v0[2] * v0[2] + v0[3] * v0[3]) + (v1[0] * v1[0] + v1[1] * v1[1]) + (v1[2] * v1[2] + v1[3] * v1[3]);
                }
                s += __shfl_xor(s, 16); s += __shfl_xor(s, 32);
                if (fq == 0) __hip_atomic_store(SS + row * 32 + u.pn * 4 + wc, s, __ATOMIC_RELAXED, __HIP_MEMORY_SCOPE_AGENT);
            }
        asm volatile("s_waitcnt vmcnt(0)" ::: "memory");
        unsigned* const pc = cnt + 64 * u.pm;
        if (lane == 0) __hip_atomic_fetch_add(pc, 1u, __ATOMIC_RELAXED, __HIP_MEMORY_SCOPE_AGENT);
        if (wid == 0) {
            if (lane == 0) {
                unsigned sp = 0;
                while (__hip_atomic_load(pc, __ATOMIC_RELAXED, __HIP_MEMORY_SCOPE_AGENT) < 64u) {
                    __builtin_amdgcn_s_sleep(2);
                    if ((++sp & 1023u) == 0u) { if (__hip_atomic_load(tmo, __ATOMIC_RELAXED, __HIP_MEMORY_SCOPE_AGENT) != 0u) break; if (sp > (1u << 20)) { __hip_atomic_store(tmo, 1u, __ATOMIC_RELAXED, __HIP_MEMORY_SCOPE_AGENT); break; } }
                }
                __builtin_amdgcn_fence(__ATOMIC_ACQUIRE, "agent");
                asm volatile("s_waitcnt vmcnt(0)" ::: "memory");
            }
        }
        asm volatile("s_waitcnt vmcnt(0) lgkmcnt(0)" ::: "memory"); __builtin_amdgcn_s_barrier(); asm volatile("" ::: "memory");
        PG8_LAS float* S = (PG8_LAS float*)(lds + 8192);
        { const int tid = wid * 64 + lane;
          if (tid < 256) {
              const float* sp_ = SS + (size_t)(u.pm * BM + tid) * 32; float t = 0.f;
#pragma unroll
              for (int k = 0; k < 8; ++k) { const f32x4 p = *(const f32x4*)(sp_ + 4 * k); t += (p[0] + p[1]) + (p[2] + p[3]); }
              S[tid] = 1.0f / sqrtf(t * (1.0f / 2048.0f) + 1e-6f);
          } }
        asm volatile("s_waitcnt lgkmcnt(0)" ::: "memory"); __builtin_amdgcn_s_barrier(); asm volatile("" ::: "memory");
        f32x4 g0[2], g1[2];
#pragma unroll
        for (int bj = 0; bj < 2; ++bj) { g0[bj] = *(const f32x4*)(G + col0 + bj * HALF); g1[bj] = *(const f32x4*)(G + col0 + bj * HALF + 4); }
#pragma unroll
        for (int ai = 0; ai < 2; ++ai) {
            f32x4 xv[4][2][2];
#pragma unroll
            for (int m = 0; m < 4; ++m) {
                const size_t off = (size_t)(u.pm * BM + ai * HALF + wr * 64 + m * 16 + fr) * 2048 + col0;
#pragma unroll
                for (int bj = 0; bj < 2; ++bj) { xv[m][bj][0] = *(const f32x4*)(X + off + bj * HALF); xv[m][bj][1] = *(const f32x4*)(X + off + bj * HALF + 4); }
            }
            asm volatile("" ::: "memory");
#pragma unroll
            for (int m = 0; m < 4; ++m) {
                const int r = ai * HALF + wr * 64 + m * 16 + fr; const float rs = S[r];
                const size_t off = (size_t)(u.pm * BM + r) * 2048 + col0;
#pragma unroll
                for (int bj = 0; bj < 2; ++bj) {
                    *(f32x4*)(Y + off + bj * HALF) = xv[m][bj][0] + acc[ai][bj][m][0] * rs * g0[bj];
                    *(f32x4*)(Y + off + bj * HALF + 4) = xv[m][bj][1] + acc[ai][bj][m][1] * rs * g1[bj];
                }
            }
            asm volatile("" ::: "memory");
        }
    }
};
}

namespace att {
#define ALDS __attribute__((address_space(3)))
typedef unsigned short bf16_t;
typedef short bf16x8 __attribute__((ext_vector_type(8)));
typedef short s16x4 __attribute__((ext_vector_type(4)));
typedef short v4i16_t __attribute__((ext_vector_type(4)));
typedef float f32x16 __attribute__((ext_vector_type(16)));
typedef unsigned u32x4 __attribute__((ext_vector_type(4)));
typedef float f32x4_t __attribute__((ext_vector_type(4)));
constexpr int PITCH = 1024;
constexpr int L_K = 0, L_V = 49152, TILE_B = 16384;
constexpr int L_XCH = 0;
constexpr float THR = 6.0f;
#define ASBAR() __builtin_amdgcn_sched_barrier(0)
#define APIN(x) asm volatile("" : "+v"(x))
__device__ __forceinline__ int crow(int r, int hi) { return (r & 3) + 8 * (r >> 2) + 4 * hi; }
typedef float f32x2_t __attribute__((ext_vector_type(2))); typedef __bf16 bf16x2_t __attribute__((ext_vector_type(2)));
__device__ __forceinline__ unsigned cvtpk(float lo, float hi) { f32x2_t v = {lo, hi}; bf16x2_t b = __builtin_convertvector(v, bf16x2_t); return __builtin_bit_cast(unsigned, b); }
__device__ __forceinline__ s16x4 vtr(const ALDS unsigned char* p) { return __builtin_bit_cast(s16x4, __builtin_amdgcn_ds_read_tr16_b64_v4i16((ALDS v4i16_t*)p)); }
__device__ __forceinline__ float bf2f(unsigned short b) { return __builtin_bit_cast(float, (unsigned)b << 16); }
__device__ __forceinline__ unsigned short f2bf(float f) { unsigned u = __builtin_bit_cast(unsigned, f); return (unsigned short)((u + 0x7fffu + ((u >> 16) & 1u)) >> 16); }
#define AMX3(a, b, c) __builtin_fmaxf(__builtin_fmaxf((a), (b)), (c))
__device__ __forceinline__ float rowmax(const f32x16& p0, const f32x16& p1) {
    float a = AMX3(p0[0], p0[1], p1[0]), b = AMX3(p0[2], p0[3], p1[1]); a = AMX3(a, p1[2], p1[3]);
#pragma unroll
    for (int r = 4; r < 16; r += 4) { a = AMX3(a, p0[r], p0[r + 1]); b = AMX3(b, p0[r + 2], p0[r + 3]); a = AMX3(a, p1[r], p1[r + 1]); b = AMX3(b, p1[r + 2], p1[r + 3]); }
    float m = __builtin_fmaxf(a, b); auto rr = __builtin_amdgcn_permlane32_swap(__float_as_uint(m), __float_as_uint(m), false, false);
    return __builtin_fmaxf(__uint_as_float(rr[0]), __uint_as_float(rr[1]));
}
struct DmaOffs { unsigned k0, k1, v0, v1; };
__device__ __forceinline__ DmaOffs dma_offsets(int wid, int lane) {
    DmaOffs D;
    { const int row = 8 * wid + (lane >> 4), c = (lane & 15) ^ (row & 15); D.k0 = (unsigned)(row * PITCH * 2 + c * 16); }
    { const int row = 8 * wid + 4 + (lane >> 4), c = (lane & 15) ^ (row & 15); D.k1 = (unsigned)(row * PITCH * 2 + c * 16); }
    { const int pv = 2 * wid, key = (pv & 3) * 16 + (lane >> 2); D.v0 = (unsigned)(key * PITCH * 2 + (pv >> 2) * 64 + (lane & 3) * 16); }
    { const int pv = 2 * wid + 1, key = (pv & 3) * 16 + (lane >> 2); D.v1 = (unsigned)(key * PITCH * 2 + (pv >> 2) * 64 + (lane & 3) * 16); }
    return D;
}
__device__ __forceinline__ void glds16(const void* gsrc, unsigned lds_dst) { unsigned keep;
    asm volatile("s_mov_b32 %0, m0\n\ts_mov_b32 m0, %2\n\ts_nop 0\n\tglobal_load_lds_dwordx4 %1, off\n\ts_mov_b32 m0, %0" : "=&s"(keep) : "v"(gsrc), "s"(lds_dst) : "memory"); }
__device__ __forceinline__ void dma_tile(const DmaOffs& D, const unsigned char* Kt, const unsigned char* Vt, unsigned kslot, unsigned vslot, int wid) {
    const unsigned kd = (unsigned)__builtin_amdgcn_readfirstlane((int)(kslot + (unsigned)wid * 2048u)), vd = (unsigned)__builtin_amdgcn_readfirstlane((int)(vslot + (unsigned)wid * 2048u));
    glds16(Kt + D.k0, kd); glds16(Kt + D.k1, kd + 1024u); glds16(Vt + D.v0, vd); glds16(Vt + D.v1, vd + 1024u);
}
struct UnitP {
    unsigned qoff;
    unsigned koff, voff;
    unsigned zoff, ooff;
    int t_begin, t_end;
    int vis_lo, vis_hi;
    int mask_tile;
    int xslot;
    int kpos0, qpos;
    const ALDS float* tab;
    int kc0;
    int out_row0;
    int hcol;
};
struct SmState { float mhat, l_reg, pend_f; bool pend; };

#define AEL(x0, x1, e) (((e) < 16) ? x0[(e) & 15] : x1[(e) & 15])

template <int ND0>
__device__ __forceinline__ void qk_plain(f32x16& n0, f32x16& n1, const ALDS unsigned char* kb, const bf16x8 (&qr)[ND0], int kc0, int r32, int hi, float cinit) {
#pragma unroll
    for (int r = 0; r < 16; ++r) { n0[r] = cinit; n1[r] = cinit; }
    bf16x8 kf[2][2];
    { const int off = (((kc0 + hi) ^ (r32 & 15)) << 4); kf[0][0] = *(const ALDS bf16x8*)(kb + off); kf[0][1] = *(const ALDS bf16x8*)(kb + 8192 + off); }
#pragma unroll
    for (int d0 = 0; d0 < ND0; ++d0) {
        if (d0 + 1 < ND0) { const int off = (((kc0 + 2 * (d0 + 1) + hi) ^ (r32 & 15)) << 4); kf[(d0 + 1) & 1][0] = *(const ALDS bf16x8*)(kb + off); kf[(d0 + 1) & 1][1] = *(const ALDS bf16x8*)(kb + 8192 + off); }
        ASBAR();
        n0 = __builtin_amdgcn_mfma_f32_32x32x16_bf16(kf[d0 & 1][0], qr[d0], n0, 0, 0, 0);
        n1 = __builtin_amdgcn_mfma_f32_32x32x16_bf16(kf[d0 & 1][1], qr[d0], n1, 0, 0, 0);
        ASBAR();
    }
}
template <int ND0>
__device__ __forceinline__ void qk_fill(f32x16& n0, f32x16& n1, const f32x16& p0, const f32x16& p1, u32x4 (&pw)[4], float& l_reg,
                                        const ALDS unsigned char* kb, const bf16x8 (&qr)[ND0], int kc0, int r32, int hi, const f32x16& negm,
                                        bool ahead, const DmaOffs& D, const unsigned char* Kt, const unsigned char* Vt, unsigned kslot, unsigned vslot, int wid) {
    constexpr int NQK = 2 * ND0, APG = 32 / NQK, PKG = 16 / NQK;
    float sa = 0.f, sb = 0.f;
    bf16x8 kf[2][2];
    { const int off = (((kc0 + hi) ^ (r32 & 15)) << 4); kf[0][0] = *(const ALDS bf16x8*)(kb + off); kf[0][1] = *(const ALDS bf16x8*)(kb + 8192 + off); }
    ASBAR();
    if (ahead) dma_tile(D, Kt, Vt, kslot, vslot, wid);
#pragma unroll
    for (int d0 = 0; d0 < ND0; ++d0) {
        if (d0 + 1 < ND0) { const int off = (((kc0 + 2 * (d0 + 1) + hi) ^ (r32 & 15)) << 4); kf[(d0 + 1) & 1][0] = *(const ALDS bf16x8*)(kb + off); kf[(d0 + 1) & 1][1] = *(const ALDS bf16x8*)(kb + 8192 + off); }
        ASBAR();
#pragma unroll
        for (int hf = 0; hf < 2; ++hf) {
            const int i = 2 * d0 + hf;
            if (hf == 0) n0 = __builtin_amdgcn_mfma_f32_32x32x16_bf16(kf[d0 & 1][0], qr[d0], (d0 == 0) ? negm : n0, 0, 0, 0);
            else         n1 = __builtin_amdgcn_mfma_f32_32x32x16_bf16(kf[d0 & 1][1], qr[d0], (d0 == 0) ? negm : n1, 0, 0, 0);
#pragma unroll
            for (int a_ = 0; a_ < APG; a_ += 2) { sa += AEL(p0, p1, i * APG + a_); sb += AEL(p0, p1, i * APG + a_ + 1); }
            APIN(sa); APIN(sb);
#pragma unroll
            for (int k = 0; k < PKG; ++k) { const int pk = i * PKG + k;
                pw[pk >> 2][pk & 3] = cvtpk(AEL(p0, p1, 2 * pk), AEL(p0, p1, 2 * pk + 1)); }
            APIN(pw[(i * PKG) >> 2]);
            ASBAR();
        }
    }
    l_reg += sa + sb;
}
__device__ __forceinline__ void bias_mask(f32x16& n0, f32x16& n1, const UnitP& U, int t, int r32, int hi, bool farb) {
    if (!farb) {
        const int base = U.kpos0 + 64 * t - (U.qpos + r32) + 4 * hi + 128;
#pragma unroll
        for (int r = 0; r < 16; ++r) {
            int i0 = base + (r & 3) + 8 * (r >> 2); int i1 = i0 + 32;
            i0 = i0 < 0 ? 0 : (i0 > 191 ? 191 : i0); i1 = i1 < 0 ? 0 : (i1 > 191 ? 191 : i1);
            n0[r] += U.tab[i0]; n1[r] += U.tab[i1];
        }
        if (t == U.mask_tile) {
#pragma unroll
            for (int r = 0; r < 16; ++r) n1[r] = -INFINITY;
        }
    }
}
template <bool WITH_EXP, bool PRE = false>
__device__ __forceinline__ void pv_fill(f32x16 (&o)[4], const u32x4 (&pw)[4], const ALDS unsigned char* vb, f32x16& n0, f32x16& n1, float& ma, float& mb, const s16x4* pl = nullptr, const s16x4* ph = nullptr) {
    s16x4 lo[2][2], hh[2][2];
#pragma unroll
    for (int j = 0; j < 2; ++j) { if (PRE) { lo[0][j] = pl[j]; hh[0][j] = ph[j]; } else { lo[0][j] = vtr(vb + j * 1024); hh[0][j] = vtr(vb + j * 1024 + 512); } }
#pragma unroll
    for (int g = 0; g < 8; ++g) {
        if (g < 7) {
#pragma unroll
            for (int j = 0; j < 2; ++j) { const int i = 2 * (g + 1) + j, d0 = i >> 2, ks = i & 3;
                lo[(g + 1) & 1][j] = vtr(vb + d0 * 4096 + ks * 1024); hh[(g + 1) & 1][j] = vtr(vb + d0 * 4096 + ks * 1024 + 512); }
        }
        ASBAR();
#pragma unroll
        for (int j = 0; j < 2; ++j) {
            const int i = 2 * g + j, d0 = i >> 2, ks = i & 3;
            const s16x4 l_ = lo[g & 1][j], h_ = hh[g & 1][j];
            const bf16x8 vf = (bf16x8){l_[0], l_[1], l_[2], l_[3], h_[0], h_[1], h_[2], h_[3]};
            o[d0] = __builtin_amdgcn_mfma_f32_32x32x16_bf16(__builtin_bit_cast(bf16x8, pw[ks]), vf, o[d0], 0, 0, 0);
            if (WITH_EXP) {
                const int e = 2 * i;
                if (e < 16) { if (i & 1) mb = AMX3(mb, n0[e & 15], n0[(e + 1) & 15]); else ma = AMX3(ma, n0[e & 15], n0[(e + 1) & 15]);
                              n0[e & 15] = __builtin_amdgcn_exp2f(n0[e & 15]); n0[(e + 1) & 15] = __builtin_amdgcn_exp2f(n0[(e + 1) & 15]); APIN(n0); }
                else { if (i & 1) mb = AMX3(mb, n1[e & 15], n1[(e + 1) & 15]); else ma = AMX3(ma, n1[e & 15], n1[(e + 1) & 15]);
                       n1[e & 15] = __builtin_amdgcn_exp2f(n1[e & 15]); n1[(e + 1) & 15] = __builtin_amdgcn_exp2f(n1[(e + 1) & 15]); APIN(n1); }
                if (i & 1) APIN(mb); else APIN(ma);
            }
            ASBAR();
        }
    }
}
__device__ __forceinline__ void drain_tile(f32x16 (&o)[4], f32x16& p0, f32x16& p1, u32x4 (&pw)[4], float& l_reg, const ALDS unsigned char* vb) {
    float sa = 0.f, sb = 0.f, sc = 0.f, sd = 0.f;
#pragma unroll
    for (int r = 0; r < 16; r += 2) { sa += p0[r]; sb += p0[r + 1]; sc += p1[r]; sd += p1[r + 1]; }
    l_reg += (sa + sb) + (sc + sd);
#pragma unroll
    for (int i = 0; i < 4; ++i) { pw[0][i] = cvtpk(p0[2 * i], p0[2 * i + 1]); pw[1][i] = cvtpk(p0[8 + 2 * i], p0[8 + 2 * i + 1]); pw[2][i] = cvtpk(p1[2 * i], p1[2 * i + 1]); pw[3][i] = cvtpk(p1[8 + 2 * i], p1[8 + 2 * i + 1]); }
    float ma_ = 0.f, mb_ = 0.f;
    pv_fill<false>(o, pw, vb, p0, p1, ma_, mb_);
}
template <int ND0>
__device__ __forceinline__ void first_step(int t, const UnitP& U, f32x16& n0, f32x16& n1, SmState& sm, const bf16x8 (&qr)[ND0], const ALDS unsigned char* kb, int r32, int hi) {
    const int relmax = U.kpos0 + 64 * t + 63 - U.qpos;
    const bool farb = (relmax <= -128);
    qk_plain<ND0>(n0, n1, kb, qr, U.kc0, r32, hi, farb ? U.tab[0] : 0.f);
    bias_mask(n0, n1, U, t, r32, hi, farb);
    const float rm = rowmax(n0, n1);
    sm.mhat = rm;
#pragma unroll
    for (int r = 0; r < 16; ++r) { n0[r] = __builtin_amdgcn_exp2f(n0[r] - rm); n1[r] = __builtin_amdgcn_exp2f(n1[r] - rm); }
}
template <int ND0>
__device__ __forceinline__ void half_a(int t, const UnitP& U, f32x16& n0, f32x16& n1, const f32x16& pp0, const f32x16& pp1, u32x4 (&pw)[4], SmState& sm, f32x16& negm, float& negc,
                                       const bf16x8 (&qr)[ND0], const ALDS unsigned char* kb, int r32, int hi, float tab0,
                                       bool ahead, const DmaOffs& D, const unsigned char* Kt, const unsigned char* Vt, unsigned kslot, unsigned vslot, int wid) {
    const int relmax = U.kpos0 + 64 * t + 63 - U.qpos;
    const bool farb = (relmax <= -128);
    { const float cin = (farb ? tab0 : 0.f) - sm.mhat;
      if (__any(cin != negc)) { negc = cin;
#pragma unroll
        for (int r = 0; r < 16; ++r) negm[r] = cin;
        APIN(negm); } }
    __builtin_amdgcn_s_setprio(1);
    qk_fill<ND0>(n0, n1, pp0, pp1, pw, sm.l_reg, kb, qr, U.kc0, r32, hi, negm, ahead, D, Kt, Vt, kslot, vslot, wid);
    __builtin_amdgcn_s_setprio(0);
    if (sm.pend) sm.l_reg *= sm.pend_f;
}
template <bool PRE = false>
__device__ __forceinline__ void half_b(int t, const UnitP& U, f32x16& n0, f32x16& n1, f32x16 (&o)[4], const u32x4 (&pw)[4], SmState& sm, const ALDS unsigned char* vbp, ALDS float* wsf, int r32, int hi, const s16x4* pl = nullptr, const s16x4* ph = nullptr) {
    const int relmax = U.kpos0 + 64 * t + 63 - U.qpos;
    bias_mask(n0, n1, U, t, r32, hi, relmax <= -128);
    float ma = -INFINITY, mb = -INFINITY;
    __builtin_amdgcn_s_setprio(1);
    pv_fill<true, PRE>(o, pw, vbp, n0, n1, ma, mb, pl, ph);
    __builtin_amdgcn_s_setprio(0);
    if (sm.pend) {
        asm volatile("s_waitcnt lgkmcnt(0)" ::: "memory");
#pragma unroll
        for (int r = 0; r < 16; ++r) { const float fr_ = wsf[crow(r, hi)];
#pragma unroll
            for (int d0 = 0; d0 < 4; ++d0) o[d0][r] *= fr_; }
        sm.pend = false;
    }
    float rm = __builtin_fmaxf(ma, mb);
    { auto rr = __builtin_amdgcn_permlane32_swap(__float_as_uint(rm), __float_as_uint(rm), false, false); rm = __builtin_fmaxf(__uint_as_float(rr[0]), __uint_as_float(rr[1])); }
    if (__any(rm > THR)) {
        const float dl = __builtin_fmaxf(rm, 0.f);
        sm.mhat += dl; sm.pend_f = __builtin_amdgcn_exp2f(-dl); sm.pend = true;
        if (hi == 0) wsf[r32] = sm.pend_f;
    }
}
template <int ND0>
__device__ __forceinline__ void simple_step(int t, bool first, const UnitP& U, f32x16& n0, f32x16& n1, f32x16 (&o)[4], u32x4 (&pw)[4], SmState& sm,
                                            const bf16x8 (&qr)[ND0], const ALDS unsigned char* kb, const ALDS unsigned char* vb, ALDS float* wsf, int r32, int hi) {
    const int relmax = U.kpos0 + 64 * t + 63 - U.qpos;
    const bool farb = (relmax <= -128);
    qk_plain<ND0>(n0, n1, kb, qr, U.kc0, r32, hi, (farb ? U.tab[0] : 0.f) - sm.mhat);
    bias_mask(n0, n1, U, t, r32, hi, farb);
    const float rm = rowmax(n0, n1);
    if (first || __any(rm > THR)) {
        const float dl = first ? rm : __builtin_fmaxf(rm, 0.f);
        sm.mhat += dl;
#pragma unroll
        for (int r = 0; r < 16; ++r) { n0[r] -= dl; n1[r] -= dl; }
        if (!first) {
            const float f = __builtin_amdgcn_exp2f(-dl); sm.l_reg *= f;
            if (hi == 0) wsf[r32] = f;
            asm volatile("s_waitcnt lgkmcnt(0)" ::: "memory");
#pragma unroll
            for (int r = 0; r < 16; ++r) { const float fr_ = wsf[crow(r, hi)];
#pragma unroll
                for (int d0 = 0; d0 < 4; ++d0) o[d0][r] *= fr_; }
        }
    }
#pragma unroll
    for (int r = 0; r < 16; ++r) { n0[r] = __builtin_amdgcn_exp2f(n0[r]); n1[r] = __builtin_amdgcn_exp2f(n1[r]); }
    drain_tile(o, n0, n1, pw, sm.l_reg, vb);
}
__device__ __forceinline__ void bias_half(f32x16& n, const UnitP& U, int t, int r32, int hi, int half) {
    const int base = U.kpos0 + 64 * t - (U.qpos + r32) + 4 * hi + 128 + 32 * half;
#pragma unroll
    for (int r = 0; r < 16; ++r) { int i0 = base + (r & 3) + 8 * (r >> 2); i0 = i0 < 0 ? 0 : (i0 > 191 ? 191 : i0); n[r] += U.tab[i0]; }
    if (half == 1 && t == U.mask_tile) {
#pragma unroll
        for (int r = 0; r < 16; ++r) n[r] = -INFINITY;
    }
}
template <int ND0>
__device__ __forceinline__ void b_step(int t, const UnitP& U, f32x16& p0, f32x16& p1, f32x16 (&o)[4], u32x4 (&pw)[4], SmState& sm,
                                       const bf16x8 (&qr)[ND0], const ALDS unsigned char* kb, const ALDS unsigned char* vb, ALDS float* wsf, int r32, int hi, float tab0) {
    const int relmax = U.kpos0 + 64 * t + 63 - U.qpos;
    const bool farb = (relmax <= -128);
    if (sm.pend) {
        sm.l_reg *= sm.pend_f;
        asm volatile("s_waitcnt lgkmcnt(0)" ::: "memory");
#pragma unroll
        for (int r = 0; r < 16; ++r) { const float fr_ = wsf[crow(r, hi)];
#pragma unroll
            for (int d0 = 0; d0 < 4; ++d0) o[d0][r] *= fr_; }
        sm.pend = false;
    }
    const float cin = (farb ? tab0 : 0.f) - sm.mhat;
#pragma unroll
    for (int r = 0; r < 16; ++r) { p0[r] = cin; p1[r] = cin; }
    float ma = -INFINITY, mb = -INFINITY, sa = 0.f, sb = 0.f;
    {
        bf16x8 kf[2];
        kf[0] = *(const ALDS bf16x8*)(kb + (((U.kc0 + hi) ^ (r32 & 15)) << 4));
        __builtin_amdgcn_s_setprio(1);
#pragma unroll
        for (int d0 = 0; d0 < ND0; ++d0) {
            if (d0 + 1 < ND0) kf[(d0 + 1) & 1] = *(const ALDS bf16x8*)(kb + (((U.kc0 + 2 * (d0 + 1) + hi) ^ (r32 & 15)) << 4));
            ASBAR();
            p0 = __builtin_amdgcn_mfma_f32_32x32x16_bf16(kf[d0 & 1], qr[d0], p0, 0, 0, 0);
            ASBAR();
        }
        __builtin_amdgcn_s_setprio(0);
    }
    if (!farb) bias_half(p0, U, t, r32, hi, 0);
    {
        bf16x8 kf[2];
        kf[0] = *(const ALDS bf16x8*)(kb + 8192 + (((U.kc0 + hi) ^ (r32 & 15)) << 4));
        __builtin_amdgcn_s_setprio(1);
#pragma unroll
        for (int d0 = 0; d0 < ND0; ++d0) {
            if (d0 + 1 < ND0) kf[(d0 + 1) & 1] = *(const ALDS bf16x8*)(kb + 8192 + (((U.kc0 + 2 * (d0 + 1) + hi) ^ (r32 & 15)) << 4));
            ASBAR();
            p1 = __builtin_amdgcn_mfma_f32_32x32x16_bf16(kf[d0 & 1], qr[d0], p1, 0, 0, 0);
            { const int e = 2 * d0;
              if (d0 & 1) mb = AMX3(mb, p0[e], p0[e + 1]); else ma = AMX3(ma, p0[e], p0[e + 1]);
              p0[e] = __builtin_amdgcn_exp2f(p0[e]); p0[e + 1] = __builtin_amdgcn_exp2f(p0[e + 1]);
              sa += p0[e]; sb += p0[e + 1];
              pw[d0 >> 2][d0 & 3] = cvtpk(p0[e], p0[e + 1]);
              APIN(p0); APIN(sa); APIN(sb); APIN(pw[d0 >> 2]); if (d0 & 1) APIN(mb); else APIN(ma); }
            ASBAR();
        }
        __builtin_amdgcn_s_setprio(0);
    }
    if (!farb) bias_half(p1, U, t, r32, hi, 1);
    {
        s16x4 lo[2], hh[2];
        lo[0] = vtr(vb); hh[0] = vtr(vb + 512);
        __builtin_amdgcn_s_setprio(1);
#pragma unroll
        for (int i = 0; i < 16; ++i) {
            const int d0 = (i & 7) >> 1, ks = (i & 1) + 2 * (i >> 3);
            if (i + 1 < 16) { const int d1 = ((i + 1) & 7) >> 1, k1 = ((i + 1) & 1) + 2 * ((i + 1) >> 3); lo[(i + 1) & 1] = vtr(vb + d1 * 4096 + k1 * 1024); hh[(i + 1) & 1] = vtr(vb + d1 * 4096 + k1 * 1024 + 512); }
            ASBAR();
            const s16x4 l_ = lo[i & 1], h_ = hh[i & 1];
            const bf16x8 vf = (bf16x8){l_[0], l_[1], l_[2], l_[3], h_[0], h_[1], h_[2], h_[3]};
            o[d0] = __builtin_amdgcn_mfma_f32_32x32x16_bf16(__builtin_bit_cast(bf16x8, pw[ks]), vf, o[d0], 0, 0, 0);
            if (i < 8) { const int e = 2 * i;
              if (i & 1) mb = AMX3(mb, p1[e], p1[e + 1]); else ma = AMX3(ma, p1[e], p1[e + 1]);
              p1[e] = __builtin_amdgcn_exp2f(p1[e]); p1[e + 1] = __builtin_amdgcn_exp2f(p1[e + 1]);
              sa += p1[e]; sb += p1[e + 1];
              pw[2 + (i >> 2)][i & 3] = cvtpk(p1[e], p1[e + 1]);
              APIN(p1); APIN(sa); APIN(sb); APIN(pw[2 + (i >> 2)]); if (i & 1) APIN(mb); else APIN(ma); }
            ASBAR();
        }
        __builtin_amdgcn_s_setprio(0);
    }
    sm.l_reg += sa + sb;
    float rm = __builtin_fmaxf(ma, mb);
    { auto rr = __builtin_amdgcn_permlane32_swap(__float_as_uint(rm), __float_as_uint(rm), false, false); rm = __builtin_fmaxf(__uint_as_float(rr[0]), __uint_as_float(rr[1])); }
    if (__any(rm > THR)) {
        const float dl = __builtin_fmaxf(rm, 0.f);
        sm.mhat += dl; sm.pend_f = __builtin_amdgcn_exp2f(-dl); sm.pend = true;
        if (hi == 0) wsf[r32] = sm.pend_f;
    }
}
__device__ __forceinline__ void store_block(const f32x16 (&v)[4], ALDS float* stage, const unsigned char* ws, unsigned zoff, unsigned ooff, int row0, int hcol, int lane, int r32, int hi) {
    u32x4 zz[8];
#pragma unroll
    for (int i = 0; i < 8; ++i) { const int idx = i * 64 + lane, row = idx >> 4, g = idx & 15;
        zz[i] = *(const u32x4*)(ws + zoff + (unsigned)((row0 + row) * PITCH + hcol + g * 8) * 2u); }
    asm volatile("" ::: "memory");
#pragma unroll
    for (int d0 = 0; d0 < 4; ++d0)
#pragma unroll
        for (int r = 0; r < 16; ++r) stage[crow(r, hi) * 128 + 32 * d0 + r32] = v[d0][r];
    asm volatile("s_waitcnt lgkmcnt(0)" ::: "memory");
#pragma unroll
    for (int i = 0; i < 8; ++i) {
        const int idx = i * 64 + lane, row = idx >> 4, g = idx & 15;
        const f32x4_t a0 = *(const ALDS f32x4_t*)(stage + row * 128 + g * 8), a1 = *(const ALDS f32x4_t*)(stage + row * 128 + g * 8 + 4);
        const unsigned off = (unsigned)((row0 + row) * PITCH + hcol + g * 8) * 2u;
        const u32x4 z = zz[i];
        u32x4 w;
        w[0] = cvtpk(a0[0] * __builtin_bit_cast(float, z[0] << 16), a0[1] * __builtin_bit_cast(float, z[0] & 0xffff0000u));
        w[1] = cvtpk(a0[2] * __builtin_bit_cast(float, z[1] << 16), a0[3] * __builtin_bit_cast(float, z[1] & 0xffff0000u));
        w[2] = cvtpk(a1[0] * __builtin_bit_cast(float, z[2] << 16), a1[1] * __builtin_bit_cast(float, z[2] & 0xffff0000u));
        w[3] = cvtpk(a1[2] * __builtin_bit_cast(float, z[3] << 16), a1[3] * __builtin_bit_cast(float, z[3] & 0xffff0000u));
        *(u32x4*)(const_cast<unsigned char*>(ws) + ooff + off) = w;
    }
}
template <int KIND>
__device__ __forceinline__ void attn_unit(const UnitP& U, const unsigned char* ws, ALDS unsigned char* lds, ALDS float* wsf, float lam, const float* subg) {
    constexpr int ND0 = (KIND == 0) ? 4 : 8;
    int tid_ = threadIdx.x; asm volatile("" : "+v"(tid_));
    const int tid = tid_, lane = tid & 63, r32 = lane & 31, hi = lane >> 5; const int wid = __builtin_amdgcn_readfirstlane(tid >> 6);
    const bool active = U.vis_lo <= U.vis_hi;
    const DmaOffs D = dma_offsets(wid, lane);
    const unsigned char* const Kg = ws + U.koff; const unsigned char* const Vg = ws + U.voff;
    constexpr size_t TSTR = (size_t)64 * PITCH * 2;
    const unsigned lds0 = (unsigned)(uintptr_t)lds;
    dma_tile(D, Kg + (size_t)U.t_begin * TSTR, Vg + (size_t)U.t_begin * TSTR, lds0 + L_K, lds0 + L_V, wid);
    if (U.t_begin + 1 < U.t_end) dma_tile(D, Kg + (size_t)(U.t_begin + 1) * TSTR, Vg + (size_t)(U.t_begin + 1) * TSTR, lds0 + L_K + TILE_B, lds0 + L_V + TILE_B, wid);
    bf16x8 qr[ND0];
#pragma unroll
    for (int d0 = 0; d0 < ND0; ++d0) qr[d0] = *(const bf16x8*)(ws + U.qoff + (unsigned)(r32 * PITCH + d0 * 16 + hi * 8) * 2u);
    f32x16 o[4];
#pragma unroll
    for (int d0 = 0; d0 < 4; ++d0) o[d0] = f32x16{};
    SmState sm; sm.mhat = 0.f; sm.l_reg = 0.f; sm.pend_f = 1.f; sm.pend = false;
    asm volatile("s_waitcnt vmcnt(0)" ::: "memory");
#pragma unroll
    for (int d0 = 0; d0 < ND0; ++d0) asm volatile("" : "+v"(qr[d0]));
    __builtin_amdgcn_s_barrier();
    const int vbo = ((lane >> 4) & 1) * 32 + (lane & 3) * 8 + (4 * hi + ((lane & 15) >> 2)) * 64;
    const float tab0 = U.tab[0];
    int kcur = 0, vcur = 0, vprev = 0, vprev2 = 0;
    const int tf = active ? ((U.vis_lo > U.t_begin) ? U.vis_lo : U.t_begin) : U.t_end, tl = active ? U.vis_hi : U.t_end;
#define ATT_KB (lds + L_K + kcur * TILE_B + r32 * 256)
#define ATT_VBP (lds + L_V + vprev * TILE_B + vbo)
#define ATT_SLOTK (lds0 + L_K + ((kcur >= 1) ? kcur - 1 : 2) * TILE_B)
#define ATT_SLOTV (lds0 + L_V + ((vcur >= 3) ? vcur - 3 : vcur + 2) * TILE_B)
#define ATT_VBP2 (lds + L_V + vprev2 * TILE_B + vbo)
#define ATT_TAIL(ahead_) do { \
        if (ahead_) asm volatile("s_waitcnt vmcnt(4)" ::: "memory"); else asm volatile("s_waitcnt vmcnt(0)" ::: "memory"); \
        asm volatile("s_waitcnt lgkmcnt(0)" ::: "memory"); \
        __builtin_amdgcn_s_barrier(); \
        kcur = (kcur == 2) ? 0 : kcur + 1; vprev2 = vprev; vprev = vcur; vcur = (vcur == 4) ? 0 : vcur + 1; \
    } while (0)
#define ATT_ITER(tt, BODY) do { \
        const bool ahead_ = ((tt) + 2 < U.t_end); \
        if (ahead_) dma_tile(D, Kg + (size_t)((tt) + 2) * TSTR, Vg + (size_t)((tt) + 2) * TSTR, ATT_SLOTK, ATT_SLOTV, wid); \
        BODY; \
        ATT_TAIL(ahead_); \
    } while (0)
#define ATT_HA(tt, N0, N1, P0, P1) half_a<ND0>((tt), U, N0, N1, P0, P1, pw, sm, negm, negc, qr, ATT_KB, r32, hi, tab0, ahead_, D, Kg + (size_t)((tt) + 2) * TSTR, Vg + (size_t)((tt) + 2) * TSTR, ATT_SLOTK, ATT_SLOTV, wid)
#define ATT_FULL(tt, N0, N1, P0, P1) do {     \
        const bool ahead_ = ((tt) + 2 < U.t_end); \
        ATT_HA(tt, N0, N1, P0, P1); \
        half_b((tt), U, N0, N1, o, pw, sm, ATT_VBP, wsf, r32, hi); \
        ATT_TAIL(ahead_); \
    } while (0)
#define ATT_G2F(tt, N0, N1, P0, P1) do {      \
        const bool ahead_ = ((tt) + 2 < U.t_end); \
        ATT_HA(tt, N0, N1, P0, P1); \
        s16x4 pl_[2], ph_[2];     \
        { const ALDS unsigned char* vb_ = ATT_VBP; _Pragma("unroll") for (int j_ = 0; j_ < 2; ++j_) { pl_[j_] = vtr(vb_ + j_ * 1024); ph_[j_] = vtr(vb_ + j_ * 1024 + 512); } } \
        ATT_TAIL(ahead_); \
        half_b<true>((tt), U, N0, N1, o, pw, sm, ATT_VBP2, wsf, r32, hi, pl_, ph_); \
    } while (0)
    int t = U.t_begin;
    for (; t < tf; ++t) ATT_ITER(t, (void)0);
    if (active) {
        if (KIND == 0 && wid < 4) {
            u32x4 pw[4]; f32x16 sA0, sA1, sB0, sB1; f32x16 negm = f32x16{}; float negc = 0.f;
            ATT_ITER(t, first_step<ND0>(t, U, sB0, sB1, sm, qr, ATT_KB, r32, hi)); ++t;
            for (; t + 1 <= tl; t += 2) {
                ATT_FULL(t, sA0, sA1, sB0, sB1);
                ATT_FULL(t + 1, sB0, sB1, sA0, sA1);
            }
            if (t <= tl) {
                ATT_FULL(t, sA0, sA1, sB0, sB1); ++t;
                sB0 = sA0; sB1 = sA1;
            }
            if (t < U.t_end) { ATT_ITER(t, drain_tile(o, sB0, sB1, pw, sm.l_reg, ATT_VBP)); ++t; }
            else drain_tile(o, sB0, sB1, pw, sm.l_reg, ATT_VBP);
        } else if (KIND == 0) {
            u32x4 pw[4]; f32x16 sA0, sA1, sB0, sB1; f32x16 negm = f32x16{}; float negc = 0.f;
            ATT_ITER(t, first_step<ND0>(t, U, sB0, sB1, sm, qr, ATT_KB, r32, hi)); ++t;
            for (; t + 1 <= tl; t += 2) {
                ATT_G2F(t, sA0, sA1, sB0, sB1);
                ATT_G2F(t + 1, sB0, sB1, sA0, sA1);
            }
            if (t <= tl) {
                ATT_G2F(t, sA0, sA1, sB0, sB1); ++t;
                sB0 = sA0; sB1 = sA1;
            }
            if (t < U.t_end) { ATT_ITER(t, drain_tile(o, sB0, sB1, pw, sm.l_reg, ATT_VBP)); ++t; }
            else drain_tile(o, sB0, sB1, pw, sm.l_reg, ATT_VBP);
        } else {
            u32x4 pw[4]; f32x16 sB0, sB1;
            ATT_ITER(t, simple_step<ND0>(t, true, U, sB0, sB1, o, pw, sm, qr, ATT_KB, lds + L_V + vcur * TILE_B + vbo, wsf, r32, hi)); ++t;
            for (; t <= tl; ++t) ATT_ITER(t, b_step<ND0>(t, U, sB0, sB1, o, pw, sm, qr, ATT_KB, lds + L_V + vcur * TILE_B + vbo, wsf, r32, hi, tab0));
        }
    }
    for (; t < U.t_end; ++t) ATT_ITER(t, (void)0);
#undef ATT_ITER
#undef ATT_FULL
#undef ATT_G2F
#undef ATT_HA
#undef ATT_TAIL
#undef ATT_SLOTK
#undef ATT_SLOTV
#undef ATT_VBP2
#undef ATT_KB
#undef ATT_VBP
    float l_reg = sm.l_reg;
    { auto rr = __builtin_amdgcn_permlane32_swap(__float_as_uint(l_reg), __float_as_uint(l_reg), false, false); l_reg = __uint_as_float(rr[0]) + __uint_as_float(rr[1]); }
    if (hi == 0) wsf[32 + r32] = l_reg;
    asm volatile("s_waitcnt lgkmcnt(0)" ::: "memory");
    float rli[16];
#pragma unroll
    for (int r = 0; r < 16; ++r) rli[r] = __builtin_amdgcn_rcpf(wsf[32 + crow(r, hi)]);
    if (KIND == 0) {
        ALDS float* xch = (ALDS float*)(lds + L_XCH);
        __syncthreads();
        if (wid >= 4 && active) {
#pragma unroll
            for (int d0 = 0; d0 < 4; ++d0)
#pragma unroll
                for (int r = 0; r < 16; ++r) xch[((U.xslot * 4 + d0) * 16 + r) * 64 + lane] = o[d0][r] * rli[r];
        }
        __syncthreads();
        if (wid < 4 && active) {
            float ss[16];
#pragma unroll
            for (int r = 0; r < 16; ++r) ss[r] = 0.f;
#pragma unroll
            for (int d0 = 0; d0 < 4; ++d0)
#pragma unroll
                for (int r = 0; r < 16; ++r) { const float x = o[d0][r] * rli[r] - lam * xch[((U.xslot * 4 + d0) * 16 + r) * 64 + lane]; o[d0][r] = x; ss[r] += x * x; }
#pragma unroll
            for (int r = 0; r < 16; ++r) {
                float s = ss[r];
                s += __shfl_xor(s, 1); s += __shfl_xor(s, 2); s += __shfl_xor(s, 4); s += __shfl_xor(s, 8); s += __shfl_xor(s, 16);
                ss[r] = __builtin_amdgcn_rsqf(s * (1.0f / 128.0f) + 1e-6f) * 0.8f;
            }
#pragma unroll
            for (int d0 = 0; d0 < 4; ++d0) {
                const float sg = subg[32 * d0 + r32];
#pragma unroll
                for (int r = 0; r < 16; ++r) o[d0][r] = o[d0][r] * ss[r] * sg;
            }
            asm volatile("s_waitcnt lgkmcnt(0)" ::: "memory");
            store_block(o, xch + U.xslot * 4096, ws, U.zoff, U.ooff, U.out_row0, U.hcol, lane, r32, hi);
        }
        __syncthreads();
    } else {
        if (active) {
#pragma unroll
            for (int d0 = 0; d0 < 4; ++d0)
#pragma unroll
                for (int r = 0; r < 16; ++r) o[d0][r] *= rli[r];
            store_block(o, (ALDS float*)(lds + wid * 16384), ws, U.zoff, U.ooff, U.out_row0, U.hcol, lane, r32, hi);
        }
    }
}
}
#define GAS __attribute__((address_space(1)))
#define LAS __attribute__((address_space(3)))
typedef unsigned short bf16;
typedef unsigned v4u __attribute__((ext_vector_type(4)));
typedef float f32x4 __attribute__((ext_vector_type(4)));
typedef short bf16x8 __attribute__((ext_vector_type(8)));
typedef GAS unsigned gu32;
typedef GAS unsigned long long gu64;
#define RLX_AGENT __ATOMIC_RELAXED, __HIP_MEMORY_SCOPE_AGENT
#define LDS_WAIT() asm volatile("s_waitcnt lgkmcnt(0)" ::: "memory")
#define VM_WAIT() asm volatile("s_waitcnt vmcnt(0)" ::: "memory")
__device__ __forceinline__ unsigned long long rt() { return __builtin_amdgcn_s_memrealtime(); }
__device__ __forceinline__ unsigned f2bf(float f) { unsigned u = __builtin_bit_cast(unsigned, f); return (u + 0x7fffu + ((u >> 16) & 1u)) >> 16; }
typedef float fp_f32x2 __attribute__((ext_vector_type(2)));
typedef __bf16 fp_bf16x2 __attribute__((ext_vector_type(2)));
__device__ __forceinline__ unsigned pk2(float lo, float hi) { fp_f32x2 v = {lo, hi}; fp_bf16x2 b = __builtin_convertvector(v, fp_bf16x2); return __builtin_bit_cast(unsigned, b); }
#define XB_TMO      128
#define XB_XCNT(j)  (256  + 64 * (j))
#define XB_XSUB(j)  (1280 + 64 * (j))
#define XB_XGEN(j)  (2304 + 64 * (j))
#define XB_TOP      3328
#define XB_TOPGEN   3392
#define XCD_BAR_WORDS 3456
#define XB_SPIN_CAP (1u << 18)

__device__ __forceinline__ unsigned xb_ld(unsigned* p)              { return __hip_atomic_load(p, __ATOMIC_RELAXED, __HIP_MEMORY_SCOPE_AGENT); }
__device__ __forceinline__ unsigned xb_add(unsigned* p, unsigned v) { return __hip_atomic_fetch_add(p, v, __ATOMIC_RELAXED, __HIP_MEMORY_SCOPE_AGENT); }
__device__ __forceinline__ unsigned xb_xcc_id() { return (unsigned)__builtin_amdgcn_s_getreg((3 << 11) | 20) & 0xFu; }
#define XB_SPIN(cond, bar) do { unsigned _sp = 0; while (cond) { __builtin_amdgcn_s_sleep(1); \
    if ((++_sp & 255u) == 0u) { if (xb_ld(&(bar)[XB_TMO])) break; if (_sp > XB_SPIN_CAP) { atomicAdd(&(bar)[XB_TMO], 1u); break; } } } } while (0)

struct XcdBarrier {
    unsigned* bar; unsigned x;
    volatile LAS unsigned* st;
};

__device__ __forceinline__ XcdBarrier xcd_barrier_post(unsigned* bar, volatile LAS unsigned* st) {
    XcdBarrier b; b.bar = bar; b.x = xb_xcc_id(); b.st = st;
    if (threadIdx.x == 0) (void)xb_add(&bar[XB_XCNT(b.x)], 1u);
    return b;
}
__device__ __forceinline__ void xcd_barrier_complete(unsigned* bar, unsigned x, unsigned& nloc, unsigned& nx) {
    const unsigned G = gridDim.x * gridDim.y * gridDim.z;
    unsigned sum, cnt, mine, sp = 0u;
    for (;;) {
        sum = 0u; cnt = 0u; mine = 0u;
#pragma unroll
        for (unsigned j = 0; j < 16; ++j) { const unsigned c = xb_ld(&bar[XB_XCNT(j)]); sum += c; cnt += (c > 0u) ? 1u : 0u; mine = (j == x) ? c : mine; }
        if (sum == G) break;
        __builtin_amdgcn_s_sleep(1);
        if ((++sp & 255u) == 0u) { if (xb_ld(&bar[XB_TMO])) break; if (sp > XB_SPIN_CAP) { atomicAdd(&bar[XB_TMO], 1u); break; } }
    }
    nloc = mine > 0u ? mine : 1u; nx = cnt > 0u ? cnt : 1u;
}

__device__ __forceinline__ void xcd_barrier(const XcdBarrier& b) {
    asm volatile("s_waitcnt vmcnt(0)" ::: "memory");
    __syncthreads();
    if (threadIdx.x == 0) {
        unsigned* bar = b.bar;
        __builtin_amdgcn_s_waitcnt(0);
        unsigned nloc = b.st[0], nx = b.st[1];
        if (nloc == 0u) { xcd_barrier_complete(bar, b.x, nloc, nx); b.st[0] = nloc; b.st[1] = nx; }
        const unsigned old = xb_add(&bar[XB_XSUB(b.x)], 1u);
        const unsigned gen = old / nloc;
        if (old + 1u == (gen + 1u) * nloc) {
            __builtin_amdgcn_fence(__ATOMIC_RELEASE, "agent");
            asm volatile("s_waitcnt vmcnt(0)" ::: "memory");
            const unsigned og = xb_add(&bar[XB_TOP], 1u);
            const unsigned tg = og / nx;
            if (og + 1u == (tg + 1u) * nx) xb_add(&bar[XB_TOPGEN], 1u);
            else XB_SPIN(xb_ld(&bar[XB_TOPGEN]) == tg, bar);
            __builtin_amdgcn_fence(__ATOMIC_ACQUIRE, "agent");
            xb_add(&bar[XB_XGEN(b.x)], 1u);
            asm volatile("s_waitcnt vmcnt(0)" ::: "memory");
        } else {
            XB_SPIN(xb_ld(&bar[XB_XGEN(b.x)]) == gen, bar);
            __builtin_amdgcn_fence(__ATOMIC_ACQUIRE, "agent");
            asm volatile("s_waitcnt vmcnt(0)" ::: "memory");
        }
    }
    __syncthreads();
}

struct Frame {
    LAS unsigned char* lds; volatile LAS unsigned* MISC; gu32* ctl;
    int tid, lane, wave, vcu, G;
};
__device__ __forceinline__ float wave_sum(float v) {
#pragma unroll
    for (int o = 1; o < 64; o <<= 1) v += __shfl_xor(v, o);
    return v;
}
__device__ __forceinline__ void p0_transpose_item(const float* W, int K, int N, bf16* WT, int row_off, LAS float* scr, int item, int lane) {
    const int nblk = N / 32, kb = item / nblk, nb = item % nblk, k0 = 64 * kb, n0 = 32 * nb;
    f32x4 v[8];
#pragma unroll
    for (int i = 0; i < 8; ++i) v[i] = __builtin_nontemporal_load((const GAS f32x4*)(W + (size_t)(k0 + 8 * i + (lane >> 3)) * N + n0 + 4 * (lane & 7)));
#pragma unroll
    for (int i = 0; i < 8; ++i) *(LAS f32x4*)(scr + (8 * i + (lane >> 3)) * 36 + 4 * (lane & 7)) = v[i];
    LDS_WAIT(); asm volatile("" ::: "memory");
    const int c = lane & 7;
#pragma unroll
    for (int j = 0; j < 4; ++j) { const int n = (lane >> 3) + 8 * j; const LAS float* s = scr + (8 * c) * 36 + n;
        v4u o; o.x = pk2(s[0 * 36], s[1 * 36]); o.y = pk2(s[2 * 36], s[3 * 36]); o.z = pk2(s[4 * 36], s[5 * 36]); o.w = pk2(s[6 * 36], s[7 * 36]);
        *(GAS v4u*)(WT + (size_t)(row_off + n0 + n) * K + k0 + 8 * c) = o; }
    LDS_WAIT(); asm volatile("" ::: "memory");
}
__device__ __forceinline__ v4u pair16(unsigned a0, unsigned a1, unsigned b0, unsigned b1, bool odd) {
    const unsigned s0 = odd ? a0 : b0, s1 = odd ? a1 : b1;
    const unsigned r0 = (unsigned)__builtin_amdgcn_mov_dpp((int)s0, 0xB1, 0xF, 0xF, true), r1 = (unsigned)__builtin_amdgcn_mov_dpp((int)s1, 0xB1, 0xF, 0xF, true);
    v4u o; o.x = odd ? r0 : a0; o.y = odd ? r1 : a1; o.z = odd ? b0 : r0; o.w = odd ? b1 : r1; return o;
}
__device__ __forceinline__ void rms_row_to_bf16(const float* xrow, const float* g, bf16* orow, int lane) {
    const GAS f32x4* xr = (const GAS f32x4*)xrow + lane; const GAS f32x4* gr = (const GAS f32x4*)g + lane;
    f32x4 v[8]; float s = 0.f;
#pragma unroll
    for (int j = 0; j < 8; ++j) { v[j] = __builtin_nontemporal_load(xr + 64 * j); s += (v[j].x * v[j].x + v[j].y * v[j].y) + (v[j].z * v[j].z + v[j].w * v[j].w); }
    const float rstd = 1.0f / sqrtf(wave_sum(s) * (1.f / 2048.f) + 1e-6f);
    const bool odd = lane & 1; GAS v4u* o16 = (GAS v4u*)(orow + (odd ? 256 : 0) + 8 * (lane >> 1));
#pragma unroll
    for (int j = 0; j < 8; j += 2) { const f32x4 ga = gr[64 * j], gb = gr[64 * j + 64];
        o16[32 * j] = pair16(pk2(v[j].x * rstd * ga.x, v[j].y * rstd * ga.y), pk2(v[j].z * rstd * ga.z, v[j].w * rstd * ga.w),
                             pk2(v[j + 1].x * rstd * gb.x, v[j + 1].y * rstd * gb.y), pk2(v[j + 1].z * rstd * gb.z, v[j + 1].w * rstd * gb.w), odd); }
}
template <int NL>
__device__ __forceinline__ void cvt_rows_1024(const float* src, bf16* dst, float* fcopy, int lane) {
    const GAS f32x4* xr = (const GAS f32x4*)src + lane; const bool odd = lane & 1; GAS v4u* o16 = (GAS v4u*)(dst + (odd ? 256 : 0) + 8 * (lane >> 1));
    f32x4 v[NL];
#pragma unroll
    for (int j = 0; j < NL; ++j) v[j] = __builtin_nontemporal_load(xr + 64 * j);
#pragma unroll
    for (int j = 0; j < NL; j += 2) {
        __builtin_nontemporal_store(pair16(pk2(v[j].x, v[j].y), pk2(v[j].z, v[j].w), pk2(v[j + 1].x, v[j + 1].y), pk2(v[j + 1].z, v[j + 1].w), odd), o16 + 32 * j);
        if (fcopy) { __builtin_nontemporal_store(v[j], (GAS f32x4*)fcopy + lane + 64 * j); __builtin_nontemporal_store(v[j + 1], (GAS f32x4*)fcopy + lane + 64 * j + 64); } }
}
__device__ __forceinline__ void zero_row_1024(bf16* dst, int lane) {
    GAS unsigned long long* o8 = (GAS unsigned long long*)dst + lane;
#pragma unroll
    for (int j = 0; j < 4; ++j) o8[64 * j] = 0ull;
}

__device__ __forceinline__ void item_done(gu32* ctr) {
    asm volatile("s_waitcnt vmcnt(0)" ::: "memory");
    __syncthreads();
    if (__builtin_amdgcn_readfirstlane(threadIdx.x >> 6) == 0) {
        if ((threadIdx.x & 63) == 0) {
            __builtin_amdgcn_fence(__ATOMIC_RELEASE, "agent");
            asm volatile("s_waitcnt vmcnt(0)" ::: "memory");
            __hip_atomic_fetch_add(ctr, 1u, RLX_AGENT);
        }
    }
}
__device__ __forceinline__ void item_wait(gu32* ctr, unsigned need, gu32* tmo) {
    if (__builtin_amdgcn_readfirstlane(threadIdx.x >> 6) == 0) {
      if ((threadIdx.x & 63) == 0) {
        unsigned sp = 0;
        while (__hip_atomic_load(ctr, RLX_AGENT) < need) {
            __builtin_amdgcn_s_sleep(8);
            if ((++sp & 1023u) == 0u) { if (__hip_atomic_load(tmo, RLX_AGENT) != 0u) break; if (sp > (1u << 20)) { __hip_atomic_store(tmo, 1u, RLX_AGENT); break; } }
        }
        __builtin_amdgcn_fence(__ATOMIC_ACQUIRE, "agent");
        asm volatile("s_waitcnt vmcnt(0)" ::: "memory");
      }
    }
    __syncthreads();
}

#if PROBE_MULT
#define TS(n) do { if (blockIdx.x == 0 && F.wave == 0) { if (F.lane == 0) { const unsigned long long t_ = wall_clock64(); F.ctl[2048 + 2 * (n)] = (unsigned)t_; F.ctl[2048 + 2 * (n) + 1] = (unsigned)(t_ >> 32); const unsigned long long c_ = __builtin_amdgcn_s_memtime(); F.ctl[2112 + 2 * (n)] = (unsigned)c_; F.ctl[2112 + 2 * (n) + 1] = (unsigned)(c_ >> 32); } } } while (0)
#else
#define TS(n) do { } while (0)
#endif
struct Args { const float* in[19]; float* out; unsigned char* ws; int pad0, pad1; };

__global__ void __launch_bounds__(NWAVES * 64, 2) fwd_kernel(Args args) {
    extern __shared__ __attribute__((aligned(16))) unsigned char lds[];
    Frame F;
    F.lds = (LAS unsigned char*)lds; F.MISC = (volatile LAS unsigned*)(F.lds + MISC_OFF);
    F.tid = threadIdx.x; F.lane = F.tid & 63; F.wave = __builtin_amdgcn_readfirstlane(F.tid >> 6);
    F.G = gridDim.x; { const int bx = blockIdx.x; F.vcu = (F.G % 8 == 0) ? (bx % 8) * (F.G / 8) + bx / 8 : bx; }
    unsigned char* ws = args.ws; float* out = args.out;
    F.ctl = (gu32*)(ws + WS_CTL);
    if (F.tid < 64) ((LAS unsigned*)(F.lds + MISC_OFF))[F.tid] = 0u;
    __syncthreads();
    XcdBarrier bar = xcd_barrier_post((unsigned*)(F.ctl + CW_BAR), F.MISC + 8);

    const int gw = F.vcu * NWAVES + F.wave, NGW = F.G * NWAVES;
    {
        const float* t5_bias = args.in[6]; const float* lq1 = args.in[10]; const float* lk1 = args.in[11]; const float* lq2 = args.in[12]; const float* lk2 = args.in[13];
        const float* rel_bias_b = args.in[15];
        LAS float* tab = (LAS float*)(F.lds + TAB_OFF);
        for (int i = F.tid; i < 8 * 192; i += NWAVES * 64) {
            const int h = i / 192, idx = i % 192, rel = idx - 128;
            const int n = rel < 0 ? -rel : rel; int bkt;
            if (n < 8) bkt = n; else { const int k = (31 - __builtin_clz((unsigned)(n * n))) - 6; bkt = 8 + k; if (bkt > 15) bkt = 15; }
            if (rel > 0) bkt += 16;
            tab[i] = t5_bias[bkt * 8 + h] * LOG2E;
            tab[8 * 192 + i] = rel_bias_b[h * 257 + idx] * LOG2E;
        }
        float s1 = lq1[F.lane] * lk1[F.lane], s2 = lq2[F.lane] * lk2[F.lane];
        s1 = wave_sum(s1); s2 = wave_sum(s2);
        const float lam0 = expf(s1) - expf(s2) + 0.2f;
        if (F.tid == 0) F.MISC[20] = __builtin_bit_cast(unsigned, lam0);
    }
    TS(0);

    for (int rep = 0; rep < REP_P0; ++rep) {
        const float* x_prompt = args.in[0]; const float* x_sample = args.in[1]; const float* pre_norm = args.in[7]; const float* w_in = args.in[9];
        bf16* WinT = (bf16*)(ws + WS_WINT); bf16* XN = (bf16*)(ws + WS_XN);
        LAS float* scr = (LAS float*)(F.lds + RING_OFF + F.wave * 16384);
        int lane0 = threadIdx.x & 63; asm volatile("" : "+v"(lane0));
        constexpr int I_IN = (DM / 64) * (NIN / 32);
        for (int it = gw; it < I_IN; it += NGW) p0_transpose_item(w_in, DM, NIN, WinT, 0, scr, it, lane0);
        for (int m = gw; m < MT; m += NGW) rms_row_to_bf16(m < SEQ ? x_prompt + (size_t)m * DM : x_sample + (size_t)(m - SEQ) * DM, pre_norm, XN + (size_t)m * DM, lane0);
    }
    xcd_barrier(bar);
    TS(1);

    {
        const int tiles = (MT / 256) * (NIN / 256), rounds = (tiles + F.G - 1) / F.G; int nG = (((tiles + rounds - 1) / rounds) + 7) & ~7; if (nG > F.G) nG = F.G;
        if ((int)blockIdx.x < nG) for (int rep = 0; rep < REP_P1; ++rep) {
            pg8::Gemm g{(const bf16*)(ws + WS_XN), (const bf16*)(ws + WS_WINT), MT, NIN, DM}; pg8::StaticOrder S; S.init(MT, NIN, nG, (int)blockIdx.x);
            pg8::EpiInProj E{ws, out};
            pg8::gemm_phase<pg8::EpiInProj, pg8::StaticOrder, true, true>(F.lds + RING_OFF, g, S, E);
        }
        TS(6);
        {
            const float* cache_k_a = args.in[2]; const float* cache_v_a = args.in[3]; const float* cache_k_b = args.in[4]; const float* cache_v_b = args.in[5];
            const float* w_o_a = args.in[16]; const float* w_o_b = args.in[17]; const float* w_out = args.in[18];
            bf16* WoT = (bf16*)(ws + WS_WOT); bf16* WoutT = (bf16*)(ws + WS_WOUTT);
            bf16 *KAs = (bf16*)(ws + WS_KAS), *VAs = (bf16*)(ws + WS_VAS), *KBs = (bf16*)(ws + WS_KBS), *VBs = (bf16*)(ws + WS_VBS);
            LAS float* scr = (LAS float*)(F.lds + RING_OFF + F.wave * 16384);
            int lane1 = threadIdx.x & 63; asm volatile("" : "+v"(lane1));
            constexpr int I_OA = (1024 / 64) * (DM / 32), I_OUT = (DM / 64) * (DM / 32);
            constexpr int N_CA = 2 * 8 * (PAST / 8), N_CB = 2 * 8 * 64, N_PAD = 4 * 8 * 32, N_TR = 2 * I_OA + I_OUT, N_SIDE = N_CA + N_CB + N_PAD + N_TR;
            for (;;) {
                unsigned base = 0;
                if (lane1 == 0) base = __hip_atomic_fetch_add(F.ctl + CW_SIDE, (unsigned)SIDE_BATCH, RLX_AGENT);
                base = (unsigned)__builtin_amdgcn_readfirstlane((int)base);
                if (base >= (unsigned)N_SIDE) break;
                const int iend = ((int)base + SIDE_BATCH < N_SIDE) ? (int)base + SIDE_BATCH : N_SIDE;
                for (int it = (int)base; it < iend; ++it) {
                    int m = it;
                    if (m < N_CA) {
                        const int which = m / (8 * (PAST / 8)), rr = (m % (8 * (PAST / 8))) * 8, b = rr / PAST, r = rr % PAST;
                        cvt_rows_1024<32>((which ? cache_v_a : cache_k_a) + (size_t)rr * 1024, (which ? VAs : KAs) + ((size_t)b * KAS_ROWS + r) * 1024, nullptr, lane1); continue; }
                    m -= N_CA;
                    if (m < N_CB) {
                        const int which = m / (8 * 64), rr = (m % (8 * 64)) * 8, b = rr / 512, r = rr % 512;
                        float* fc = (r >= 32) ? out + (which ? O_VBS : O_KBS) + ((size_t)b * 512 + (r - 32)) * 1024 : nullptr;
                        cvt_rows_1024<32>((which ? cache_v_b : cache_k_b) + (size_t)rr * 1024, (which ? VBs : KBs) + ((size_t)b * KBS_ROWS + r) * 1024, fc, lane1); continue; }
                    m -= N_CB;
                    if (m < N_PAD) {
                        const int which = m / 256, rr = m % 256, b = rr / 32, r = rr % 32;
                        bf16* d = which == 0 ? KAs + ((size_t)b * KAS_ROWS + PAST + 32 + r) * 1024 : which == 1 ? VAs + ((size_t)b * KAS_ROWS + PAST + 32 + r) * 1024
                                : which == 2 ? KBs + ((size_t)b * KBS_ROWS + 544 + r) * 1024 : VBs + ((size_t)b * KBS_ROWS + 544 + r) * 1024;
                        zero_row_1024(d, lane1); continue; }
                    m -= N_PAD;
                    if (m < I_OA) { p0_transpose_item(w_o_a, 1024, DM, WoT, 0, scr, m, lane1); continue; } m -= I_OA;
                    if (m < I_OA) { p0_transpose_item(w_o_b, 1024, DM, WoT, 2048, scr, m, lane1); continue; } m -= I_OA;
                    p0_transpose_item(w_out, DM, DM, WoutT, 0, scr, m, lane1);
                }
            }
        }
    }
    const int NQ = (ATT_NQ8 && F.G % 8 == 0) ? 8 : 1, xq = (NQ == 8) ? (int)(blockIdx.x & 7) : 0, QLEN = 896 / NQ;
    int have_first = 0;
    if (blockIdx.x >= 8) {
        have_first = 1;
        if (F.wave == 0) { if (F.lane == 0) F.MISC[16] = __hip_atomic_fetch_add((unsigned*)(F.ctl + CW_QUEUE + 32 * xq), 1u, __ATOMIC_RELAXED, __HIP_MEMORY_SCOPE_AGENT); }
    }
    xcd_barrier(bar);
    TS(2);

    {
        if (blockIdx.x < 8) {
            const int pn = (int)blockIdx.x; int n_two = 2, n_one = 1; asm volatile("" : "+s"(n_two), "+s"(n_one));
            item_wait(F.ctl + CW_DONE_S, 128u, F.ctl + CW_TMO);
            {
                pg8::Gemm g{(const bf16*)(ws + WS_GATED), (const bf16*)(ws + WS_WOT), 2 * MT, 4096, 1024}; pg8::MergeOne S{pn, n_two};
                pg8::EpiMerge E{ws, WS_MMS - (size_t)SEQ * 2048 * 2};
                pg8::gemm_phase<pg8::EpiMerge, pg8::MergeOne, true, true>(F.lds + RING_OFF, g, S, E);
            }
            item_done(F.ctl + CW_DONE_M3);
            item_wait(F.ctl + CW_DONE_M3, 8u, F.ctl + CW_TMO);
            {
                pg8::Gemm g{(const bf16*)(ws + WS_MMS), (const bf16*)(ws + WS_WOUTT), 256, DM, DM}; pg8::OutOne S{pn, n_one};
                pg8::EpiOutNorm E{args.in[1], out + O_Y + (size_t)SEQ * DM, args.in[8], (float*)(ws + WS_SS) + (size_t)SEQ * 32, (unsigned*)(F.ctl + CW_PANEL + 64 * 32), (unsigned*)(F.ctl + CW_TMO)};
                pg8::gemm_phase<pg8::EpiOutNorm, pg8::OutOne, false, true>(F.lds + RING_OFF, g, S, E);
            }
        }
        const float* subln = args.in[14];
        LAS float* tab = (LAS float*)(F.lds + TAB_OFF);
        const float lam = __builtin_bit_cast(float, (unsigned)F.MISC[20]);
        LAS float* wsf = (LAS float*)(F.lds + WSF_OFF) + F.wave * 64;
        const int w = F.wave, g = w >> 2, j = w & 3;
#if PROBE_MULT
        if (F.wave == 0) { if (F.lane == 0) { F.MISC[16] = 0xFFFFFFFFu; F.MISC[40] = (unsigned)wall_clock64(); } }
#endif
        int pend = 0;
        for (;;) {
            asm volatile("s_waitcnt vmcnt(0)" ::: "memory");
            __syncthreads();
            if (F.wave == 0) {
                if (F.lane == 0) {
                    if (pend) { __builtin_amdgcn_fence(__ATOMIC_RELEASE, "agent"); asm volatile("s_waitcnt vmcnt(0)" ::: "memory"); __hip_atomic_fetch_add(F.ctl + CW_DONE_S, 1u, RLX_AGENT); }
#if PROBE_MULT
                    { const unsigned tn = (unsigned)wall_clock64(), pu = F.MISC[16]; const int pk = (pu == 0xFFFFFFFFu) ? 4 : (pu < 64u) ? 1 : (pu < 128u) ? 3 : (pu < 584u) ? 0 : (pu < 840u) ? 2 : 0;
                      F.MISC[32 + pk] += tn - F.MISC[40]; F.MISC[40] = tn; }
#endif
                    if (!have_first) F.MISC[16] = __hip_atomic_fetch_add((unsigned*)(F.ctl + CW_QUEUE + 32 * xq), 1u, __ATOMIC_RELAXED, __HIP_MEMORY_SCOPE_AGENT);
                }
            }
            __syncthreads();
            const int ui = __builtin_amdgcn_readfirstlane((int)F.MISC[16]);
            have_first = 0;
            __syncthreads();
            if (ui >= QLEN) {
#if PROBE_MULT
                if (F.wave == 0) { if (F.lane == 0) { const unsigned long long t_ = wall_clock64(); gu32* pb = F.ctl + 12288 + 8 * blockIdx.x; pb[6] = (unsigned)t_; pb[7] = (unsigned)(t_ >> 32);
                    for (int k = 0; k < 5; ++k) pb[k] = F.MISC[32 + k]; } }
#endif
                break;
            }
            const int h = (NQ == 8) ? xq : ui % 8, u = (NQ == 8) ? ui : ui / 8;
            int kind, q;
            if (u < 16) { kind = (u < 8) ? 1 : 3; q = u & 7; }
            else if (u < 73) { kind = 0; q = 63 - (u - 16); }
            else if (u < 105) { kind = 2; q = 31 - (u - 73); }
            else { kind = 0; q = 6 - (u - 105); }
            att::UnitP U; U.hcol = h * 128; U.mask_tile = -1; U.kpos0 = 0; U.t_begin = 0;
            if (kind < 2) {
                const int row0 = (kind == 0) ? 128 * q + 32 * j : SEQ + 32 * q;
                U.qoff = (unsigned)WS_QA + (unsigned)(row0 * 1024 + h * 128 + g * 64) * 2u; U.qpos = (kind == 0) ? row0 : PAST; U.out_row0 = row0; U.tab = tab + h * 192; U.kc0 = 8 * g; U.vis_lo = 0; U.xslot = (kind == 0) ? j : 0;
                U.zoff = (unsigned)WS_ZA; U.ooff = (unsigned)WS_GATED;
                if (kind == 0) { U.koff = (unsigned)WS_KA + h * 256; U.voff = (unsigned)WS_VA + h * 256; U.t_end = 2 * q + 2; U.vis_hi = 2 * q + (j >> 1); }
                else { U.koff = (unsigned)WS_KAS + (unsigned)(q * KAS_ROWS * 1024 + h * 128) * 2u; U.voff = (unsigned)WS_VAS + (unsigned)(q * KAS_ROWS * 1024 + h * 128) * 2u; U.t_end = 33; U.vis_hi = (j == g) ? 32 : -1; U.mask_tile = 32; }
                att::attn_unit<0>(U, ws, F.lds + RING_OFF, wsf, lam, subln);
            } else {
                const int row0 = (kind == 2) ? 256 * q + 32 * w : SEQ + 32 * q;
                U.qoff = (unsigned)WS_QB + (unsigned)(row0 * 1024 + h * 128) * 2u; U.qpos = (kind == 2) ? row0 : PAST; U.out_row0 = row0; U.tab = tab + (8 + h) * 192; U.kc0 = 0;
                U.zoff = (unsigned)WS_ZB; U.ooff = (unsigned)(WS_GATED + (size_t)MT * 1024 * 2);
                if (kind == 2) { const int cw = 4 * q + (w >> 1); U.koff = (unsigned)WS_KB + h * 256; U.voff = (unsigned)WS_VB + h * 256; U.t_begin = (4 * q - 8 > 0) ? 4 * q - 8 : 0; U.t_end = 4 * q + 4; U.vis_lo = cw - 8; U.vis_hi = cw; }
                else { U.koff = (unsigned)WS_KBS + (unsigned)(q * KBS_ROWS * 1024 + h * 128) * 2u; U.voff = (unsigned)WS_VBS + (unsigned)(q * KBS_ROWS * 1024 + h * 128) * 2u; U.t_end = 9; U.vis_lo = 0; U.vis_hi = (w == 0) ? 8 : -1; U.mask_tile = 8; U.kpos0 = PAST - 512; }
                att::attn_unit<1>(U, ws, F.lds + RING_OFF, wsf, lam, subln);
            }
            pend = (kind & 1);
        }
    }
    xcd_barrier(bar);
    TS(3);

    for (int rep = 0; rep < REP_P3; ++rep) {
        pg8::Gemm g{(const bf16*)(ws + WS_GATED), (const bf16*)(ws + WS_WOT), 2 * MT, 4096, 1024}; pg8::MergeOrder S{F.vcu, F.G};
        pg8::EpiMerge E{ws, WS_MM};
        pg8::gemm_phase<pg8::EpiMerge, pg8::MergeOrder, true, true>(F.lds + RING_OFF, g, S, E);
    }
    xcd_barrier(bar);
    TS(4);

    for (int rep = 0; rep < REP_P4; ++rep) {
        pg8::Gemm g{(const bf16*)(ws + WS_MM), (const bf16*)(ws + WS_WOUTT), MT, DM, DM}; pg8::OutOrder S{F.vcu, F.G};
        pg8::EpiOutNorm E{args.in[0], out + O_Y, args.in[8], (float*)(ws + WS_SS), (unsigned*)(F.ctl + CW_PANEL), (unsigned*)(F.ctl + CW_TMO)};
        pg8::gemm_phase<pg8::EpiOutNorm, pg8::OutOrder, false, true>(F.lds + RING_OFF, g, S, E);
    }
#if PROBE_MULT
    asm volatile("s_waitcnt vmcnt(0)" ::: "memory");
    __syncthreads();
    TS(5);
    if (blockIdx.x == 0 && F.wave == 0) { if (F.lane == 0) {
        const unsigned long long ta = (unsigned long long)F.ctl[2048 + 2 * PROBE_A] | ((unsigned long long)F.ctl[2048 + 2 * PROBE_A + 1] << 32);
        const unsigned long long tb = (unsigned long long)F.ctl[2048 + 2 * PROBE_B] | ((unsigned long long)F.ctl[2048 + 2 * PROBE_B + 1] << 32);
        const unsigned long long t5 = (unsigned long long)F.ctl[2048 + 10] | ((unsigned long long)F.ctl[2048 + 11] << 32);
#if PROBE_A == 9
        unsigned long long sum = 0;
        for (int b = 0; b < (int)gridDim.x; ++b) { const unsigned long long te = (unsigned long long)__hip_atomic_load(F.ctl + 12288 + 8 * b + 6, RLX_AGENT) | ((unsigned long long)__hip_atomic_load(F.ctl + 12288 + 8 * b + 7, RLX_AGENT) << 32); sum += tb - te; }
        const unsigned long long d = sum * (unsigned long long)PROBE_MULT / gridDim.x;
#elif PROBE_A == 8
        const unsigned long long ca = (unsigned long long)F.ctl[2112 + 2 * (PROBE_B - 1)] | ((unsigned long long)F.ctl[2112 + 2 * (PROBE_B - 1) + 1] << 32);
        const unsigned long long cb = (unsigned long long)F.ctl[2112 + 2 * PROBE_B] | ((unsigned long long)F.ctl[2112 + 2 * PROBE_B + 1] << 32);
        const unsigned long long d = (cb - ca) / 20ull * (unsigned long long)PROBE_MULT;
#elif PROBE_A >= 10
        unsigned long long sum = 0;
        for (int b = 0; b < (int)gridDim.x; ++b) sum += __hip_atomic_load(F.ctl + 12288 + 8 * b + (PROBE_A - 10), RLX_AGENT);
        const unsigned long long d = sum * (unsigned long long)PROBE_MULT / gridDim.x;
#else
        const unsigned long long d = (tb - ta) * (unsigned long long)PROBE_MULT;
#endif
        while (wall_clock64() - t5 < d) __builtin_amdgcn_s_sleep(16);
    } }
#endif
}

extern "C" void kernel_launch(void* const* d_in, const int* in_sizes, int n_in, void* d_out, int out_size, void* d_ws, size_t ws_size, hipStream_t stream) {
    static int grid = 0;
    if (grid == 0) {
        if (n_in != 19 || out_size != 44040192 || ws_size < WS_END) { fprintf(stderr, "kernel_launch: unexpected problem (n_in %d, out %d, ws %zu)\n", n_in, out_size, ws_size); grid = -1; return; }
        int dev = 0, cus = 0, per_cu = 0;
        if (hipGetDevice(&dev) != hipSuccess || hipDeviceGetAttribute(&cus, hipDeviceAttributeMultiprocessorCount, dev) != hipSuccess) { grid = -1; return; }
        if (hipFuncSetAttribute((const void*)fwd_kernel, hipFuncAttributeMaxDynamicSharedMemorySize, LDS_BYTES) != hipSuccess) { fprintf(stderr, "kernel_launch: hipFuncSetAttribute failed\n"); grid = -1; return; }
        if (hipOccupancyMaxActiveBlocksPerMultiprocessor(&per_cu, (const void*)fwd_kernel, NWAVES * 64, LDS_BYTES) != hipSuccess || per_cu < 1) { fprintf(stderr, "kernel_launch: occupancy query says %d blocks per CU\n", per_cu); grid = -1; (void)hipGetLastError(); return; }
        (void)hipGetLastError();
        grid = cus;
    }
    if (grid < 0) return;
    (void)hipMemsetAsync((char*)d_ws + WS_CTL, 0, CTL_ZERO_BYTES, stream);
    Args a{};
    for (int i = 0; i < 19; ++i) a.in[i] = (const float*)d_in[i];
    a.out = (float*)d_out; a.ws = (unsigned char*)d_ws;
    hipLaunchKernelGGL(fwd_kernel, dim3(grid), dim3(NWAVES * 64), LDS_BYTES, stream, a);
}
```

```cpp
#include <hip/hip_runtime.h>
#include <hip/hip_bf16.h>
#include <cstdio>
#include <cstdint>
namespace pg8 {
#define PG8_LAS __attribute__((address_space(3)))
typedef unsigned short bf16_t;
typedef short bf16x8 __attribute__((ext_vector_type(8)));
typedef float f32x4 __attribute__((ext_vector_type(4)));
typedef unsigned u32x4 __attribute__((ext_vector_type(4)));
constexpr int BM = 256, BK = 64, HALF = 128, HTB = HALF * BK * 2  , STAGE_BYTES = 8 * HTB, NXCD = 8, WGM = 4;

__host__ __device__ __forceinline__ int lds_byte(int r, int c) { const int st = (r >> 4) * 2 + (c >> 5), rr = r & 15, cc = c & 31, ob = rr * 64 + cc * 2; return st * 1024 + (ob ^ (((ob >> 9) & 1) << 5)); }
__host__ __device__ __forceinline__ void stage_rc(int b, int& R, int& C) { const int st = b / 1024, sb = b % 1024, swz = sb ^ (((sb >> 9) & 1) << 5); R = (st >> 1) * 16 + swz / 64; C = (st & 1) * 32 + (swz % 64) / 2; }
__host__ __device__ __forceinline__ int perm32(int rho) { const int n = rho >> 4, i = rho & 15; return 8 * (i >> 2) + 4 * n + (i & 3); }

struct Unit { int pm, pn; };
struct Gemm { const bf16_t* A; const bf16_t* Bt; int M, N, K; };

struct StaticOrder {
    int nM, nN, nwg, G, c;
    __host__ __device__ void init(int M, int N, int G_, int c_) { nM = M / BM; nN = N / BM; nwg = nM * nN; G = G_; c = c_; }
    __host__ __device__ bool next(int i, Unit& u) const {
        const long L = (long)i * G + c; if (L >= nwg) return false;
        int wgid = (int)L; { const int q = nwg / NXCD, r = nwg % NXCD, xcd = wgid % NXCD, off = wgid / NXCD; wgid = (xcd < r ? xcd * (q + 1) : r * (q + 1) + (xcd - r) * q) + off; }
        const int nig = WGM * nN, gid = wgid / nig, fm = gid * WGM, gsz = (nM - fm) < WGM ? (nM - fm) : WGM;
        u.pm = fm + ((wgid % nig) % gsz); u.pn = (wgid % nig) / gsz; return true;
    }
    __device__ __forceinline__ void a_ready(const Unit&) const {}
    __device__ __forceinline__ void done(const Unit&) const {}
};

__device__ __forceinline__ unsigned cvt_pk_bf16(float lo, float hi) { unsigned r; asm volatile("v_cvt_pk_bf16_f32 %0, %1, %2" : "=v"(r) : "v"(lo), "v"(hi)); return r; }
typedef float f32x2 __attribute__((ext_vector_type(2)));
template <class Epi, class Sched, bool ALIGN_EPI = false, bool SP2 = false>
__device__ __forceinline__ void gemm_phase(PG8_LAS unsigned char* lds, const Gemm g, const Sched& S, const Epi& E) {
    int tid_ = threadIdx.x; asm volatile("" : "+v"(tid_));
    const int tid = tid_, wid = __builtin_amdgcn_readfirstlane(tid >> 6), lane = tid & 63, wr = wid >> 2, wc = wid & 3, fr = lane & 15, fq = lane >> 4;
    const int K = g.K, nt = K / BK;
    unsigned voffA[2], voffB[2];
#pragma unroll
    for (int i = 0; i < 2; ++i) { int R, C; stage_rc(tid * 16 + i * 8192, R, C); const int Rb = Epi::PERM ? ((R & ~31) + perm32(R & 31)) : R;
        voffA[i] = (unsigned)(R * K + C) * 2u; voffB[i] = (unsigned)(Rb * K + C) * 2u; }
    const size_t kstep = (size_t)(BK * 2);
    const size_t hstep = (size_t)HALF * K * 2;
    const size_t tstep = 2 * hstep;
    const unsigned ldsw = (unsigned)wid * 1024u;
    const int aoff = lds_byte(wr * 64 + fr, fq * 8), boff = lds_byte(wc * 32 + fr, fq * 8);
#define PG8_SA(b, h) (((b) * 2 + (h)) * HTB)
#define PG8_SB(b, h) ((4 + (b) * 2 + (h)) * HTB)
#define PG8_STAGE(bufoff, gbase, voff) do { _Pragma("unroll") for (int _i = 0; _i < 2; ++_i) \
        __builtin_amdgcn_global_load_lds((const unsigned*)((const char*)(gbase) + (voff)[_i]), (PG8_LAS unsigned*)(lds + (bufoff) + ldsw + _i * 8192), 16, 0, 0); } while (0)
#define PG8_LDA(dst, b, h) do { _Pragma("unroll") for (int m = 0; m < 4; ++m) _Pragma("unroll") for (int k = 0; k < 2; ++k) dst[m][k] = *(const PG8_LAS bf16x8*)(lds + PG8_SA(b, h) + aoff + m * 2048 + k * 1024); } while (0)
#define PG8_LDB(dst, b, h) do { _Pragma("unroll") for (int n = 0; n < 2; ++n) _Pragma("unroll") for (int k = 0; k < 2; ++k) dst[n][k] = *(const PG8_LAS bf16x8*)(lds + PG8_SB(b, h) + boff + n * 2048 + k * 1024); } while (0)
#define PG8_MMA(ai, bj, At, Bt) do { __builtin_amdgcn_s_setprio(1); _Pragma("unroll") for (int m = 0; m < 4; ++m) _Pragma("unroll") for (int n = 0; n < 2; ++n) _Pragma("unroll") for (int k = 0; k < 2; ++k) \
        acc[ai][bj][m][n] = __builtin_amdgcn_mfma_f32_16x16x32_bf16(Bt[n][k], At[m][k], acc[ai][bj][m][n], 0, 0, 0); __builtin_amdgcn_s_setprio(0); } while (0)
#define PG8_WAIT_V(n) asm volatile("s_waitcnt vmcnt(" #n ")" ::: "memory")
#define PG8_WAIT_L(n) asm volatile("s_waitcnt lgkmcnt(" #n ")" ::: "memory")
#define PG8_BAR __builtin_amdgcn_s_barrier()
#define PG8_SCHED __builtin_amdgcn_sched_barrier(0)
    Unit cur, nxt; int ui = 0;
    if (!S.next(0, cur)) return;
    f32x4 acc[2][2][4][2];
#pragma unroll
    for (int a = 0; a < 2; ++a)
#pragma unroll
        for (int b = 0; b < 2; ++b)
#pragma unroll
            for (int m = 0; m < 4; ++m)
#pragma unroll
                for (int n = 0; n < 2; ++n) acc[a][b][m][n] = (f32x4){0.f, 0.f, 0.f, 0.f};
    bf16x8 At[4][2], B0[2][2], B1[2][2];
    const char* cA = (const char*)g.A + (size_t)cur.pm * tstep; const char* cB = (const char*)g.Bt + (size_t)cur.pn * tstep;
    S.a_ready(cur);
    if constexpr (SP2) {
        PG8_STAGE(PG8_SB(0, 0), cB, voffB); PG8_STAGE(PG8_SB(0, 1), cB + hstep, voffB); PG8_STAGE(PG8_SA(0, 0), cA, voffA); PG8_STAGE(PG8_SA(0, 1), cA + hstep, voffA);
        if (wr == 1) PG8_BAR;
        PG8_WAIT_V(2); PG8_BAR;
        PG8_STAGE(PG8_SB(1, 0), cB + kstep, voffB); PG8_STAGE(PG8_SA(1, 0), cA + kstep, voffA); PG8_STAGE(PG8_SB(1, 1), cB + hstep + kstep, voffB);
        PG8_WAIT_V(6); PG8_BAR;
    } else {
        PG8_STAGE(PG8_SB(0, 0), cB, voffB); PG8_STAGE(PG8_SA(0, 0), cA, voffA); PG8_STAGE(PG8_SB(0, 1), cB + hstep, voffB); PG8_STAGE(PG8_SA(0, 1), cA + hstep, voffA);
        if (wr == 1) PG8_BAR;
        PG8_WAIT_V(4); PG8_BAR;
        PG8_STAGE(PG8_SB(1, 0), cB + kstep, voffB); PG8_STAGE(PG8_SA(1, 0), cA + kstep, voffA); PG8_STAGE(PG8_SB(1, 1), cB + hstep + kstep, voffB);
        PG8_WAIT_V(6); PG8_BAR;
    }
    for (;;) {
        const bool has_next = S.next(ui + 1, nxt);
        const char* nA = has_next ? (const char*)g.A + (size_t)nxt.pm * tstep : cA; const char* nB = has_next ? (const char*)g.Bt + (size_t)nxt.pn * tstep : cB;
        for (int t = 0; t < nt; t += 2) {
            const bool last = (t == nt - 2);
            const char* a1 = cA + (size_t)(t + 1) * kstep;
            const char* a2 = last ? nA : cA + (size_t)(t + 2) * kstep; const char* b2 = last ? nB : cB + (size_t)(t + 2) * kstep;
            const char* a3 = a2 + kstep; const char* b3 = b2 + kstep;
            if (last && has_next) S.a_ready(nxt);
            if constexpr (SP2) {
            PG8_LDB(B0, 0, 0); PG8_LDB(B1, 0, 1); PG8_SCHED; PG8_LDA(At, 0, 0); PG8_STAGE(PG8_SA(1, 1), a1 + hstep, voffA);
            PG8_WAIT_V(8); PG8_WAIT_L(0); PG8_BAR; PG8_MMA(0, 0, At, B0); PG8_MMA(0, 1, At, B1); PG8_BAR; PG8_SCHED;
            PG8_LDA(At, 0, 1); PG8_STAGE(PG8_SB(0, 0), b2, voffB); PG8_STAGE(PG8_SB(0, 1), b2 + hstep, voffB); PG8_STAGE(PG8_SA(0, 0), a2, voffA);
            PG8_WAIT_V(8); PG8_WAIT_L(0); PG8_BAR; PG8_MMA(1, 0, At, B0); PG8_MMA(1, 1, At, B1); PG8_BAR; PG8_SCHED;
            PG8_LDB(B0, 1, 0); PG8_LDB(B1, 1, 1); PG8_SCHED; PG8_LDA(At, 1, 0); PG8_STAGE(PG8_SA(0, 1), a2 + hstep, voffA);
            PG8_WAIT_V(8); PG8_WAIT_L(0); PG8_BAR; PG8_MMA(0, 0, At, B0); PG8_MMA(0, 1, At, B1); PG8_BAR; PG8_SCHED;
            PG8_LDA(At, 1, 1); PG8_STAGE(PG8_SB(1, 0), b3, voffB); PG8_STAGE(PG8_SB(1, 1), b3 + hstep, voffB); PG8_STAGE(PG8_SA(1, 0), a3, voffA);
            PG8_WAIT_V(8); PG8_WAIT_L(0); PG8_BAR; PG8_MMA(1, 0, At, B0); PG8_MMA(1, 1, At, B1); PG8_BAR; PG8_SCHED;
            } else {
            PG8_LDB(B0, 0, 0); PG8_SCHED; PG8_LDA(At, 0, 0); PG8_STAGE(PG8_SA(1, 1), a1 + hstep, voffA);
            PG8_WAIT_L(8); PG8_BAR; PG8_WAIT_L(0); PG8_MMA(0, 0, At, B0); PG8_BAR; PG8_SCHED;
            PG8_LDB(B1, 0, 1); PG8_STAGE(PG8_SB(0, 0), b2, voffB);
            PG8_BAR; PG8_WAIT_L(0); PG8_MMA(0, 1, At, B1); PG8_BAR;
            PG8_LDA(At, 0, 1); PG8_STAGE(PG8_SA(0, 0), a2, voffA);
            PG8_BAR; PG8_WAIT_L(0); PG8_MMA(1, 0, At, B0); PG8_BAR; PG8_SCHED;
            PG8_STAGE(PG8_SB(0, 1), b2 + hstep, voffB);
            PG8_WAIT_V(6); PG8_BAR; PG8_MMA(1, 1, At, B1); PG8_BAR;
            PG8_LDB(B0, 1, 0); PG8_SCHED; PG8_LDA(At, 1, 0); PG8_STAGE(PG8_SA(0, 1), a2 + hstep, voffA);
            PG8_WAIT_L(8); PG8_BAR; PG8_WAIT_L(0); PG8_MMA(0, 0, At, B0); PG8_BAR; PG8_SCHED;
            PG8_LDB(B1, 1, 1); PG8_STAGE(PG8_SB(1, 0), b3, voffB);
            PG8_BAR; PG8_WAIT_L(0); PG8_MMA(0, 1, At, B1); PG8_BAR;
            PG8_LDA(At, 1, 1); PG8_STAGE(PG8_SA(1, 0), a3, voffA);
            PG8_BAR; PG8_WAIT_L(0); PG8_MMA(1, 0, At, B0); PG8_BAR; PG8_SCHED;
            PG8_STAGE(PG8_SB(1, 1), b3 + hstep, voffB);
            PG8_WAIT_V(6); PG8_BAR; PG8_MMA(1, 1, At, B1); PG8_BAR;
            }
        }
        if constexpr (ALIGN_EPI) { if (wr == 0) PG8_BAR; }
        if constexpr (!Epi::AFTER_DRAIN) { E(acc, cur, wr, wc, fr, fq); S.done(cur); }
        if (!has_next) break;
#pragma unroll
        for (int a = 0; a < 2; ++a)
#pragma unroll
            for (int b = 0; b < 2; ++b)
#pragma unroll
                for (int m = 0; m < 4; ++m)
#pragma unroll
                    for (int n = 0; n < 2; ++n) acc[a][b][m][n] = (f32x4){0.f, 0.f, 0.f, 0.f};
        cur = nxt; cA = nA; cB = nB; ++ui;
        if constexpr (ALIGN_EPI) { if (wr == 1) PG8_BAR; }
    }
    PG8_WAIT_V(0);
    if constexpr (!ALIGN_EPI) { if (wr == 0) PG8_BAR; }
    PG8_BAR;
    if constexpr (Epi::AFTER_DRAIN) { E.fused(acc, cur, wr, wc, fr, fq, lds, wid, lane); S.done(cur); }
#undef PG8_SA
#undef PG8_SB
#undef PG8_STAGE
#undef PG8_LDA
#undef PG8_LDB
#undef PG8_MMA
#undef PG8_WAIT_V
#undef PG8_WAIT_L
#undef PG8_BAR
#undef PG8_SCHED
}
}

constexpr int DM = 2048, SEQ = 8192, NSMP = 256, MT = SEQ + NSMP  , NIN = 12288;
constexpr int PAST = 2048, KAS_ROWS = 2112  , KBS_ROWS = 576  ;
constexpr float LOG2E = 1.4426950408889634f;
constexpr float QSCALE_A = 0.125f * LOG2E;
constexpr float QSCALE_B = 0.08838834764831845f * LOG2E;
constexpr size_t O_Y = 0, O_KAP = 17301504, O_VAP = 25690112, O_KBP = 34078720, O_VBP = 34603008, O_KAS = 35127296, O_VAS = 35389440, O_KBS = 35651584, O_VBS = 39845888;


#ifndef REP_P0
#define REP_P0 1
#endif
#ifndef REP_P3
#define REP_P3 1
#endif
#ifndef REP_P4
#define REP_P4 1
#endif
#ifndef REP_SW
#define REP_SW 1
#endif
#ifndef ATT_NQ8
#define ATT_NQ8 0
#endif
#ifndef PROBE_MULT
#define PROBE_MULT 0
#define PROBE_A 0
#define PROBE_B 1
#endif
#ifndef REP_P1
#define REP_P1 1
#endif
#ifndef REP_P2
#define REP_P2 1
#endif
constexpr int NWAVES = 8;
constexpr size_t MiB = 1u << 20;
constexpr size_t WS_CTL = 0, CTL_ZERO_BYTES = 65536;
constexpr size_t WS_SS = 382 * MiB;
constexpr size_t WS_MMS = 66 * MiB;
constexpr size_t WS_WOT = 2 * MiB;
constexpr size_t WS_WOUTT = 10 * MiB;
constexpr size_t WS_WINT = 18 * MiB;
constexpr size_t WS_XN = 66 * MiB;
constexpr size_t WS_GATED = 18 * MiB;
constexpr size_t WS_Y = 99 * MiB;
constexpr size_t SZ_R = (size_t)MT * 1024 * 2;
constexpr size_t WS_QA = WS_Y, WS_KA = WS_QA + SZ_R, WS_VA = WS_KA + SZ_R, WS_ZA = WS_VA + SZ_R, WS_QB = WS_ZA + SZ_R, WS_KB = WS_QB + SZ_R, WS_VB = WS_KB + SZ_R, WS_ZB = WS_VB + SZ_R;
constexpr size_t WS_GA = WS_ZB + SZ_R, WS_GB = WS_GA + 2 * SZ_R, WS_YEND = WS_GB + 2 * SZ_R;
constexpr size_t WS_MM = WS_Y;
constexpr size_t WS_KAS = 298 * MiB;
constexpr size_t SZ_KAS = (size_t)8 * KAS_ROWS * 1024 * 2, SZ_KBS = (size_t)8 * KBS_ROWS * 1024 * 2;
constexpr size_t WS_VAS = WS_KAS + SZ_KAS, WS_KBS = WS_VAS + SZ_KAS, WS_VBS = WS_KBS + SZ_KBS, WS_DEND = WS_VBS + SZ_KBS;
constexpr size_t WS_PART = WS_KAS;
constexpr size_t WS_END = 384 * MiB;
static_assert(WS_SS + (size_t)MT * 32 * 4 <= WS_END && WS_DEND <= WS_SS && WS_YEND <= WS_KAS && WS_DEND <= WS_END && WS_PART + (size_t)MT * 2048 * 4 <= WS_END && WS_XN + (size_t)MT * 2048 * 2 <= WS_Y && WS_GATED + (size_t)2 * MT * 1024 * 2 <= WS_XN, "d_ws map");
constexpr int CW_QUEUE = 64;
constexpr int CW_DONE_S = 1024, CW_DONE_M3 = 1088, CW_TMO = 32, CW_PANEL = 8192;
constexpr int CW_SIDE = 1152, SIDE_BATCH = 8;
constexpr int CW_BAR = 4096;
constexpr int RING_OFF = 0, RING_BYTES = 131072;
constexpr int MISC_OFF = RING_BYTES;
constexpr int TAB_OFF = RING_BYTES + 256;
constexpr int WSF_OFF = TAB_OFF + 2 * 8 * 192 * 4;
constexpr int LDS_BYTES = 147456;
static_assert(WSF_OFF + 8 * 64 * 4 <= LDS_BYTES, "LDS map");

namespace pg8 {
__device__ __forceinline__ float fast_sigmoid(float v) { return __builtin_amdgcn_rcpf(1.0f + __builtin_amdgcn_exp2f(-v * 1.4426950408889634f)); }
__device__ __forceinline__ float bf2f(unsigned short b) { return __builtin_bit_cast(float, (unsigned)b << 16); }

struct EpiInProj {
    static constexpr bool PERM = true, AFTER_DRAIN = false;
    unsigned char* ws; float* out;
    __device__ __forceinline__ void operator()(const f32x4 (&acc)[2][2][4][2], const Unit& u, int wr, int wc, int fr, int fq) const {
        const int pn = u.pn, T = pn >> 2; const bool smp = (u.pm == 32);
        size_t bbase; int bpitch = 1024, act = 0; float scale = 1.f; size_t fbase = 0; int lc0;
        int brow0 = u.pm * BM + wr * 64 + fr, bSA = 128, bSM = 32;
        int fmode = 0, frow0 = 0, fSA = 128, fSM = 32;
        if (T < 8) {
            lc0 = (pn & 3) * 256 + wc * 32 + 8 * fq;
            bbase = WS_QA + (size_t)T * SZ_R;
            if (T == 0) scale = QSCALE_A; else if (T == 4) scale = QSCALE_B; else if (T == 3 || T == 7) act = 1;
            else if (T == 1 || T == 2) {
                fmode = 1; frow0 = (smp ? 0 : u.pm * BM) + wr * 64 + fr; fbase = (T == 1) ? (smp ? O_KAS : O_KAP) : (smp ? O_VAS : O_VAP);
                if (smp) { bbase = (T == 1) ? WS_KAS : WS_VAS; brow0 = wr * 2 * KAS_ROWS + PAST + fr; bSA = 4 * KAS_ROWS; bSM = KAS_ROWS; }
            } else {
                if (smp) { fmode = 1; frow0 = wr * 2 * 512 + 480 + fr; fSA = 4 * 512; fSM = 512; fbase = (T == 5) ? O_KBS : O_VBS;
                           bbase = (T == 5) ? WS_KBS : WS_VBS; brow0 = wr * 2 * KBS_ROWS + 512 + fr; bSA = 4 * KBS_ROWS; bSM = KBS_ROWS; }
                else if (u.pm >= 30) { fmode = 1; frow0 = u.pm * BM - 7680 + wr * 64 + fr; fbase = (T == 5) ? O_KBP : O_VBP; }
            }
        } else { bpitch = 2048; act = 2; if (pn < 40) { bbase = WS_GA; lc0 = (pn - 32) * 256 + wc * 32 + 8 * fq; } else { bbase = WS_GB; lc0 = (pn - 40) * 256 + wc * 32 + 8 * fq; } }
        bf16_t* const bdst = (bf16_t*)(ws + bbase); float* const fdst = out + fbase;
        const unsigned boff0 = (unsigned)brow0 * (unsigned)bpitch + (unsigned)lc0, bSAo = (unsigned)bSA * (unsigned)bpitch, bSMo = (unsigned)bSM * (unsigned)bpitch, b16 = 16u * (unsigned)bpitch;
        const unsigned foff0 = (unsigned)frow0 * 1024u + (unsigned)lc0, fSAo = (unsigned)fSA * 1024u, fSMo = (unsigned)fSM * 1024u;
#pragma unroll
        for (int ai = 0; ai < 2; ++ai)
#pragma unroll
            for (int m = 0; m < 4; ++m) {
                const unsigned boff = boff0 + ai * bSAo + (m >> 1) * bSMo + (m & 1) * b16;
                const unsigned foff = foff0 + ai * fSAo + (m >> 1) * fSMo + (m & 1) * 16384u;
#pragma unroll
                for (int bj = 0; bj < 2; ++bj) {
                    f32x4 v0 = acc[ai][bj][m][0], v1 = acc[ai][bj][m][1];
                    if (fmode != 0) { float* fp = fdst + (foff + bj * HALF); *(f32x4*)fp = v0; *(f32x4*)(fp + 4) = v1; }
                    if (act == 0) { v0 = v0 * scale; v1 = v1 * scale; }
                    else {
#pragma unroll
                        for (int e = 0; e < 4; ++e) { const float s0 = fast_sigmoid(v0[e]), s1 = fast_sigmoid(v1[e]); v0[e] = (act == 1) ? v0[e] * s0 : s0; v1[e] = (act == 1) ? v1[e] * s1 : s1; }
                    }
                    u32x4 w; w.x = cvt_pk_bf16(v0[0], v0[1]); w.y = cvt_pk_bf16(v0[2], v0[3]); w.z = cvt_pk_bf16(v1[0], v1[1]); w.w = cvt_pk_bf16(v1[2], v1[3]);
                    *(u32x4*)(bdst + (boff + bj * HALF)) = w;
                }
                asm volatile("" ::: "memory");
            }
    }
};

struct EpiMerge {
    static constexpr bool PERM = true, AFTER_DRAIN = false;
    unsigned char* ws; size_t mm_off;
    __device__ __forceinline__ void operator()(const f32x4 (&acc)[2][2][4][2], const Unit& u, int wr, int wc, int fr, int fq) const {
        const int part = (u.pm >= 33) ? 1 : 0, pm = u.pm - 33 * part, pn = u.pn - 8 * part;
#if PROBE_MULT
        if (blockIdx.x == 0 && threadIdx.x == 0 && mm_off == WS_MM) { const unsigned long long t_ = wall_clock64(); unsigned* c_ = (unsigned*)(ws + WS_CTL); c_[2048 + 2 * (7 + 2 * part)] = (unsigned)t_; c_[2048 + 2 * (7 + 2 * part) + 1] = (unsigned)(t_ >> 32); }
#endif
        const bf16_t* G = (const bf16_t*)(ws + (part ? WS_GB : WS_GA)); bf16_t* const PART = (bf16_t*)(ws + WS_PART); bf16_t* const Od = (bf16_t*)(ws + (part ? mm_off : WS_PART));
        const int col0 = pn * BM + wc * 32 + 8 * fq;
#pragma unroll
        for (int ai = 0; ai < 2; ++ai) {
          u32x4 gwv[4][2], pwv[4][2];
#pragma unroll
          for (int m = 0; m < 4; ++m)
#pragma unroll
            for (int bj = 0; bj < 2; ++bj) gwv[m][bj] = *(const u32x4*)(G + ((size_t)(pm * BM + ai * HALF + wr * 64 + m * 16 + fr) * 2048 + col0 + bj * HALF));
          if (part == 1) {
#pragma unroll
            for (int m = 0; m < 4; ++m)
#pragma unroll
              for (int bj = 0; bj < 2; ++bj) pwv[m][bj] = *(const u32x4*)(PART + ((size_t)(pm * BM + ai * HALF + wr * 64 + m * 16 + fr) * 2048 + col0 + bj * HALF));
          } else {
#pragma unroll
            for (int m = 0; m < 4; ++m)
#pragma unroll
              for (int bj = 0; bj < 2; ++bj) pwv[m][bj] = u32x4{0u, 0u, 0u, 0u};
          }
          asm volatile("" ::: "memory");
#pragma unroll
            for (int m = 0; m < 4; ++m) {
                const size_t row = (size_t)(pm * BM + ai * HALF + wr * 64 + m * 16 + fr);
#pragma unroll
                for (int bj = 0; bj < 2; ++bj) {
                    const size_t off = row * 2048 + col0 + bj * HALF;
                    const u32x4 gw = gwv[m][bj];
                    f32x4 g0, g1;
                    g0[0] = __builtin_bit_cast(float, gw.x << 16); g0[1] = __builtin_bit_cast(float, gw.x & 0xffff0000u); g0[2] = __builtin_bit_cast(float, gw.y << 16); g0[3] = __builtin_bit_cast(float, gw.y & 0xffff0000u);
                    g1[0] = __builtin_bit_cast(float, gw.z << 16); g1[1] = __builtin_bit_cast(float, gw.z & 0xffff0000u); g1[2] = __builtin_bit_cast(float, gw.w << 16); g1[3] = __builtin_bit_cast(float, gw.w & 0xffff0000u);
                    f32x4 v0 = acc[ai][bj][m][0] * g0, v1 = acc[ai][bj][m][1] * g1;
                    {
                        const u32x4 pw = pwv[m][bj];
                        v0[0] += __builtin_bit_cast(float, pw.x << 16); v0[1] += __builtin_bit_cast(float, pw.x & 0xffff0000u); v0[2] += __builtin_bit_cast(float, pw.y << 16); v0[3] += __builtin_bit_cast(float, pw.y & 0xffff0000u);
                        v1[0] += __builtin_bit_cast(float, pw.z << 16); v1[1] += __builtin_bit_cast(float, pw.z & 0xffff0000u); v1[2] += __builtin_bit_cast(float, pw.w << 16); v1[3] += __builtin_bit_cast(float, pw.w & 0xffff0000u);
                    }
                    u32x4 w; w.x = cvt_pk_bf16(v0[0], v0[1]); w.y = cvt_pk_bf16(v0[2], v0[3]); w.z = cvt_pk_bf16(v1[0], v1[1]); w.w = cvt_pk_bf16(v1[2], v1[3]);
                    *(u32x4*)(Od + off) = w;
                }
            }
        }
#if PROBE_MULT
        if (blockIdx.x == 0 && threadIdx.x == 0 && mm_off == WS_MM) { asm volatile("s_waitcnt vmcnt(0)" ::: "memory"); const unsigned long long t_ = wall_clock64(); unsigned* c_ = (unsigned*)(ws + WS_CTL); c_[2048 + 2 * (8 + 2 * part)] = (unsigned)t_; c_[2048 + 2 * (8 + 2 * part) + 1] = (unsigned)(t_ >> 32); }
#endif
    }
};
struct MergeOrder {
    int c, G;
    __device__ __forceinline__ bool next(int i, Unit& u) const {
        const int ti = i >> 1, part = i & 1; const int L = ti * G + c;
        if (L >= 256) return false;
        u.pm = L / 8 + 33 * part; u.pn = L % 8 + 8 * part; return true;
    }
    __device__ __forceinline__ void a_ready(const Unit&) const {}
    __device__ __forceinline__ void done(const Unit&) const {}
};
struct MergeOne {
    int pn, n;
    __device__ __forceinline__ bool next(int i, Unit& u) const { if (i >= n) return false; u.pm = 32 + 33 * i; u.pn = pn + 8 * i; return true; }
    __device__ __forceinline__ void a_ready(const Unit&) const {}
    __device__ __forceinline__ void done(const Unit&) const {}
};
struct OutOne {
    int pn, n;
    __device__ __forceinline__ bool next(int i, Unit& u) const { if (i >= n) return false; u.pm = 0; u.pn = pn; return true; }
    __device__ __forceinline__ void a_ready(const Unit&) const {}
    __device__ __forceinline__ void done(const Unit&) const {}
};
struct OutOrder {
    int c, G;
    __device__ __forceinline__ bool next(int i, Unit& u) const {
        const int L = i * G + c;
        if (L >= 256) return false;
        u.pm = L / 8; u.pn = L % 8; return true;
    }
    __device__ __forceinline__ void a_ready(const Unit&) const {}
    __device__ __forceinline__ void done(const Unit&) const {}
};
struct EpiOutNorm {
    static constexpr bool PERM = true, AFTER_DRAIN = true;
    const float* X; float* Y; const float* G;
    float* SS;
    unsigned* cnt; unsigned* tmo;
    __device__ __forceinline__ void fused(f32x4 (&acc)[2][2][4][2], const Unit& u, int wr, int wc, int fr, int fq, PG8_LAS unsigned char* lds, int wid, int lane) const {
        const int col0 = u.pn * BM + wc * 32 + 8 * fq;
#pragma unroll
        for (int ai = 0; ai < 2; ++ai)
#pragma unroll
            for (int m = 0; m < 4; ++m) {
                const size_t row = (size_t)(u.pm * BM + ai * HALF + wr * 64 + m * 16 + fr);
                float s = 0.f;
#pragma unroll
                for (int bj = 0; bj < 2; ++bj) {
                    const f32x4 v0 = acc[ai][bj][m][0], v1 = acc[ai][bj][m][1];
                    s += (v0[0] * v0[0] + v0[1] * v0[1]) + (v0[2] * v0[2] + v0[3] * v0[3]) + (v1[0] * v1[0] + v1[1] * v1[1]) + (v1[2] * v1[2] + v1[3] * v1[3]);
                }
                s += __shfl_xor(s, 16); s += __shfl_xor(s, 32);
                if (fq == 0) __hip_atomic_store(SS + row * 32 + u.pn * 4 + wc, s, __ATOMIC_RELAXED, __HIP_MEMORY_SCOPE_AGENT);
            }
        asm volatile("s_waitcnt vmcnt(0)" ::: "memory");
        unsigned* const pc = cnt + 64 * u.pm;
        if (lane == 0) __hip_atomic_fetch_add(pc, 1u, __ATOMIC_RELAXED, __HIP_MEMORY_SCOPE_AGENT);
        if (wid == 0) {
            if (lane == 0) {
                unsigned sp = 0;
                while (__hip_atomic_load(pc, __ATOMIC_RELAXED, __HIP_MEMORY_SCOPE_AGENT) < 64u) {
                    __builtin_amdgcn_s_sleep(2);
                    if ((++sp & 1023u) == 0u) { if (__hip_atomic_load(tmo, __ATOMIC_RELAXED, __HIP_MEMORY_SCOPE_AGENT) != 0u) break; if (sp > (1u << 20)) { __hip_atomic_store(tmo, 1u, __ATOMIC_RELAXED, __HIP_MEMORY_SCOPE_AGENT); break; } }
                }
                __builtin_amdgcn_fence(__ATOMIC_ACQUIRE, "agent");
                asm volatile("s_waitcnt vmcnt(0)" ::: "memory");
            }
        }
        asm volatile("s_waitcnt vmcnt(0) lgkmcnt(0)" ::: "memory"); __builtin_amdgcn_s_barrier(); asm volatile("" ::: "memory");
        PG8_LAS float* S = (PG8_LAS float*)(lds + 8192);
        { const int tid = wid * 64 + lane;
          if (tid < 256) {
              const float* sp_ = SS + (size_t)(u.pm * BM + tid) * 32; float t = 0.f;
#pragma unroll
              for (int k = 0; k < 8; ++k) { const f32x4 p = *(const f32x4*)(sp_ + 4 * k); t += (p[0] + p[1]) + (p[2] + p[3]); }
              S[tid] = 1.0f / sqrtf(t * (1.0f / 2048.0f) + 1e-6f);
          } }
        asm volatile("s_waitcnt lgkmcnt(0)" ::: "memory"); __builtin_amdgcn_s_barrier(); asm volatile("" ::: "memory");
        f32x4 g0[2], g1[2];
#pragma unroll
        for (int bj = 0; bj < 2; ++bj) { g0[bj] = *(const f32x4*)(G + col0 + bj * HALF); g1[bj] = *(const f32x4*)(G + col0 + bj * HALF + 4); }
#pragma unroll
        for (int ai = 0; ai < 2; ++ai) {
            f32x4 xv[4][2][2];
#pragma unroll
            for (int m = 0; m < 4; ++m) {
                const size_t off = (size_t)(u.pm * BM + ai * HALF + wr * 64 + m * 16 + fr) * 2048 + col0;
#pragma unroll
                for (int bj = 0; bj < 2; ++bj) { xv[m][bj][0] = *(const f32x4*)(X + off + bj * HALF); xv[m][bj][1] = *(const f32x4*)(X + off + bj * HALF + 4); }
            }
            asm volatile("" ::: "memory");
#pragma unroll
            for (int m = 0; m < 4; ++m) {
                const int r = ai * HALF + wr * 64 + m * 16 + fr; const float rs = S[r];
                const size_t off = (size_t)(u.pm * BM + r) * 2048 + col0;
#pragma unroll
                for (int bj = 0; bj < 2; ++bj) {
                    *(f32x4*)(Y + off + bj * HALF) = xv[m][bj][0] + acc[ai][bj][m][0] * rs * g0[bj];
                    *(f32x4*)(Y + off + bj * HALF + 4) = xv[m][bj][1] + acc[ai][bj][m][1] * rs * g1[bj];
                }
            }
            asm volatile("" ::: "memory");
        }
    }
};
}

namespace att {
#define ALDS __attribute__((address_space(3)))
typedef unsigned short bf16_t;
typedef short bf16x8 __attribute__((ext_vector_type(8)));
typedef short s16x4 __attribute__((ext_vector_type(4)));
typedef short v4i16_t __attribute__((ext_vector_type(4)));
typedef float f32x16 __attribute__((ext_vector_type(16)));
typedef unsigned u32x4 __attribute__((ext_vector_type(4)));
typedef float f32x4_t __attribute__((ext_vector_type(4)));
constexpr int PITCH = 1024;
constexpr int L_K = 0, L_V = 49152, TILE_B = 16384;
constexpr int L_XCH = 0;
constexpr float THR = 6.0f;
#define ASBAR() __builtin_amdgcn_sched_barrier(0)
#define APIN(x) asm volatile("" : "+v"(x))
__device__ __forceinline__ int crow(int r, int hi) { return (r & 3) + 8 * (r >> 2) + 4 * hi; }
typedef float f32x2_t __attribute__((ext_vector_type(2))); typedef __bf16 bf16x2_t __attribute__((ext_vector_type(2)));
__device__ __forceinline__ unsigned cvtpk(float lo, float hi) { f32x2_t v = {lo, hi}; bf16x2_t b = __builtin_convertvector(v, bf16x2_t); return __builtin_bit_cast(unsigned, b); }
__device__ __forceinline__ s16x4 vtr(const ALDS unsigned char* p) { return __builtin_bit_cast(s16x4, __builtin_amdgcn_ds_read_tr16_b64_v4i16((ALDS v4i16_t*)p)); }
__device__ __forceinline__ float bf2f(unsigned short b) { return __builtin_bit_cast(float, (unsigned)b << 16); }
__device__ __forceinline__ unsigned short f2bf(float f) { unsigned u = __builtin_bit_cast(unsigned, f); return (unsigned short)((u + 0x7fffu + ((u >> 16) & 1u)) >> 16); }
#define AMX3(a, b, c) __builtin_fmaxf(__builtin_fmaxf((a), (b)), (c))
__device__ __forceinline__ float rowmax(const f32x16& p0, const f32x16& p1) {
    float a = AMX3(p0[0], p0[1], p1[0]), b = AMX3(p0[2], p0[3], p1[1]); a = AMX3(a, p1[2], p1[3]);
#pragma unroll
    for (int r = 4; r < 16; r += 4) { a = AMX3(a, p0[r], p0[r + 1]); b = AMX3(b, p0[r + 2], p0[r + 3]); a = AMX3(a, p1[r], p1[r + 1]); b = AMX3(b, p1[r + 2], p1[r + 3]); }
    float m = __builtin_fmaxf(a, b); auto rr = __builtin_amdgcn_permlane32_swap(__float_as_uint(m), __float_as_uint(m), false, false);
    return __builtin_fmaxf(__uint_as_float(rr[0]), __uint_as_float(rr[1]));
}
struct DmaOffs { unsigned k0, k1, v0, v1; };
__device__ __forceinline__ DmaOffs dma_offsets(int wid, int lane) {
    DmaOffs D;
    { const int row = 8 * wid + (lane >> 4), c = (lane & 15) ^ (row & 15); D.k0 = (unsigned)(row * PITCH * 2 + c * 16); }
    { const int row = 8 * wid + 4 + (lane >> 4), c = (lane & 15) ^ (row & 15); D.k1 = (unsigned)(row * PITCH * 2 + c * 16); }
    { const int pv = 2 * wid, key = (pv & 3) * 16 + (lane >> 2); D.v0 = (unsigned)(key * PITCH * 2 + (pv >> 2) * 64 + (lane & 3) * 16); }
    { const int pv = 2 * wid + 1, key = (pv & 3) * 16 + (lane >> 2); D.v1 = (unsigned)(key * PITCH * 2 + (pv >> 2) * 64 + (lane & 3) * 16); }
    return D;
}
__device__ __forceinline__ void glds16(const void* gsrc, unsigned lds_dst) { unsigned keep;
    asm volatile("s_mov_b32 %0, m0\n\ts_mov_b32 m0, %2\n\ts_nop 0\n\tglobal_load_lds_dwordx4 %1, off\n\ts_mov_b32 m0, %0" : "=&s"(keep) : "v"(gsrc), "s"(lds_dst) : "memory"); }
__device__ __forceinline__ void dma_tile(const DmaOffs& D, const unsigned char* Kt, const unsigned char* Vt, unsigned kslot, unsigned vslot, int wid) {
    const unsigned kd = (unsigned)__builtin_amdgcn_readfirstlane((int)(kslot + (unsigned)wid * 2048u)), vd = (unsigned)__builtin_amdgcn_readfirstlane((int)(vslot + (unsigned)wid * 2048u));
    glds16(Kt + D.k0, kd); glds16(Kt + D.k1, kd + 1024u); glds16(Vt + D.v0, vd); glds16(Vt + D.v1, vd + 1024u);
}
struct UnitP {
    unsigned qoff;
    unsigned koff, voff;
    unsigned zoff, ooff;
    int t_begin, t_end;
    int vis_lo, vis_hi;
    int mask_tile;
    int xslot;
    int kpos0, qpos;
    const ALDS float* tab;
    int kc0;
    int out_row0;
    int hcol;
};
struct SmState { float mhat, l_reg, pend_f; bool pend; };

#define AEL(x0, x1, e) (((e) < 16) ? x0[(e) & 15] : x1[(e) & 15])

template <int ND0>
__device__ __forceinline__ void qk_plain(f32x16& n0, f32x16& n1, const ALDS unsigned char* kb, const bf16x8 (&qr)[ND0], int kc0, int r32, int hi, float cinit) {
#pragma unroll
    for (int r = 0; r < 16; ++r) { n0[r] = cinit; n1[r] = cinit; }
    bf16x8 kf[2][2];
    { const int off = (((kc0 + hi) ^ (r32 & 15)) << 4); kf[0][0] = *(const ALDS bf16x8*)(kb + off); kf[0][1] = *(const ALDS bf16x8*)(kb + 8192 + off); }
#pragma unroll
    for (int d0 = 0; d0 < ND0; ++d0) {
        if (d0 + 1 < ND0) { const int off = (((kc0 + 2 * (d0 + 1) + hi) ^ (r32 & 15)) << 4); kf[(d0 + 1) & 1][0] = *(const ALDS bf16x8*)(kb + off); kf[(d0 + 1) & 1][1] = *(const ALDS bf16x8*)(kb + 8192 + off); }
        ASBAR();
        n0 = __builtin_amdgcn_mfma_f32_32x32x16_bf16(kf[d0 & 1][0], qr[d0], n0, 0, 0, 0);
        n1 = __builtin_amdgcn_mfma_f32_32x32x16_bf16(kf[d0 & 1][1], qr[d0], n1, 0, 0, 0);
        ASBAR();
    }
}
template <int ND0>
__device__ __forceinline__ void qk_fill(f32x16& n0, f32x16& n1, const f32x16& p0, const f32x16& p1, u32x4 (&pw)[4], float& l_reg,
                                        const ALDS unsigned char* kb, const bf16x8 (&qr)[ND0], int kc0, int r32, int hi, const f32x16& negm,
                                        bool ahead, const DmaOffs& D, const unsigned char* Kt, const unsigned char* Vt, unsigned kslot, unsigned vslot, int wid) {
    constexpr int NQK = 2 * ND0, APG = 32 / NQK, PKG = 16 / NQK;
    float sa = 0.f, sb = 0.f;
    bf16x8 kf[2][2];
    { const int off = (((kc0 + hi) ^ (r32 & 15)) << 4); kf[0][0] = *(const ALDS bf16x8*)(kb + off); kf[0][1] = *(const ALDS bf16x8*)(kb + 8192 + off); }
    ASBAR();
    if (ahead) dma_tile(D, Kt, Vt, kslot, vslot, wid);
#pragma unroll
    for (int d0 = 0; d0 < ND0; ++d0) {
        if (d0 + 1 < ND0) { const int off = (((kc0 + 2 * (d0 + 1) + hi) ^ (r32 & 15)) << 4); kf[(d0 + 1) & 1][0] = *(const ALDS bf16x8*)(kb + off); kf[(d0 + 1) & 1][1] = *(const ALDS bf16x8*)(kb + 8192 + off); }
        ASBAR();
#pragma unroll
        for (int hf = 0; hf < 2; ++hf) {
            const int i = 2 * d0 + hf;
            if (hf == 0) n0 = __builtin_amdgcn_mfma_f32_32x32x16_bf16(kf[d0 & 1][0], qr[d0], (d0 == 0) ? negm : n0, 0, 0, 0);
            else         n1 = __builtin_amdgcn_mfma_f32_32x32x16_bf16(kf[d0 & 1][1], qr[d0], (d0 == 0) ? negm : n1, 0, 0, 0);
#pragma unroll
            for (int a_ = 0; a_ < APG; a_ += 2) { sa += AEL(p0, p1, i * APG + a_); sb += AEL(p0, p1, i * APG + a_ + 1); }
            APIN(sa); APIN(sb);
#pragma unroll
            for (int k = 0; k < PKG; ++k) { const int pk = i * PKG + k;
                pw[pk >> 2][pk & 3] = cvtpk(AEL(p0, p1, 2 * pk), AEL(p0, p1, 2 * pk + 1)); }
            APIN(pw[(i * PKG) >> 2]);
            ASBAR();
        }
    }
    l_reg += sa + sb;
}
__device__ __forceinline__ void bias_mask(f32x16& n0, f32x16& n1, const UnitP& U, int t, int r32, int hi, bool farb) {
    if (!farb) {
        const int base = U.kpos0 + 64 * t - (U.qpos + r32) + 4 * hi + 128;
#pragma unroll
        for (int r = 0; r < 16; ++r) {
            int i0 = base + (r & 3) + 8 * (r >> 2); int i1 = i0 + 32;
            i0 = i0 < 0 ? 0 : (i0 > 191 ? 191 : i0); i1 = i1 < 0 ? 0 : (i1 > 191 ? 191 : i1);
            n0[r] += U.tab[i0]; n1[r] += U.tab[i1];
        }
        if (t == U.mask_tile) {
#pragma unroll
            for (int r = 0; r < 16; ++r) n1[r] = -INFINITY;
        }
    }
}
template <bool WITH_EXP>
__device__ __forceinline__ void pv_fill(f32x16 (&o)[4], const u32x4 (&pw)[4], const ALDS unsigned char* vb, f32x16& n0, f32x16& n1, float& ma, float& mb) {
    s16x4 lo[2][2], hh[2][2];
#pragma unroll
    for (int j = 0; j < 2; ++j) { lo[0][j] = vtr(vb + j * 4096); hh[0][j] = vtr(vb + j * 4096 + 512); }
#pragma unroll
    for (int g = 0; g < 8; ++g) {
        if (g < 7) {
#pragma unroll
            for (int j = 0; j < 2; ++j) { const int i = 2 * (g + 1) + j, ks = i >> 2, d0 = i & 3;
                lo[(g + 1) & 1][j] = vtr(vb + d0 * 4096 + ks * 1024); hh[(g + 1) & 1][j] = vtr(vb + d0 * 4096 + ks * 1024 + 512); }
        }
        ASBAR();
#pragma unroll
        for (int j = 0; j < 2; ++j) {
            const int i = 2 * g + j, ks = i >> 2, d0 = i & 3;
            const s16x4 l_ = lo[g & 1][j], h_ = hh[g & 1][j];
            const bf16x8 vf = (bf16x8){l_[0], l_[1], l_[2], l_[3], h_[0], h_[1], h_[2], h_[3]};
            o[d0] = __builtin_amdgcn_mfma_f32_32x32x16_bf16(__builtin_bit_cast(bf16x8, pw[ks]), vf, o[d0], 0, 0, 0);
            if (WITH_EXP) {
                const int e = 2 * i;
                if (e < 16) { if (i & 1) mb = AMX3(mb, n0[e & 15], n0[(e + 1) & 15]); else ma = AMX3(ma, n0[e & 15], n0[(e + 1) & 15]);
                              n0[e & 15] = __builtin_amdgcn_exp2f(n0[e & 15]); n0[(e + 1) & 15] = __builtin_amdgcn_exp2f(n0[(e + 1) & 15]); APIN(n0); }
                else { if (i & 1) mb = AMX3(mb, n1[e & 15], n1[(e + 1) & 15]); else ma = AMX3(ma, n1[e & 15], n1[(e + 1) & 15]);
                       n1[e & 15] = __builtin_amdgcn_exp2f(n1[e & 15]); n1[(e + 1) & 15] = __builtin_amdgcn_exp2f(n1[(e + 1) & 15]); APIN(n1); }
                if (i & 1) APIN(mb); else APIN(ma);
            }
            ASBAR();
        }
    }
}
__device__ __forceinline__ void drain_tile(f32x16 (&o)[4], f32x16& p0, f32x16& p1, u32x4 (&pw)[4], float& l_reg, const ALDS unsigned char* vb) {
    float sa = 0.f, sb = 0.f, sc = 0.f, sd = 0.f;
#pragma unroll
    for (int r = 0; r < 16; r += 2) { sa += p0[r]; sb += p0[r + 1]; sc += p1[r]; sd += p1[r + 1]; }
    l_reg += (sa + sb) + (sc + sd);
#pragma unroll
    for (int i = 0; i < 4; ++i) { pw[0][i] = cvtpk(p0[2 * i], p0[2 * i + 1]); pw[1][i] = cvtpk(p0[8 + 2 * i], p0[8 + 2 * i + 1]); pw[2][i] = cvtpk(p1[2 * i], p1[2 * i + 1]); pw[3][i] = cvtpk(p1[8 + 2 * i], p1[8 + 2 * i + 1]); }
    float ma_ = 0.f, mb_ = 0.f;
    pv_fill<false>(o, pw, vb, p0, p1, ma_, mb_);
}
template <int ND0>
__device__ __forceinline__ void first_step(int t, const UnitP& U, f32x16& n0, f32x16& n1, SmState& sm, const bf16x8 (&qr)[ND0], const ALDS unsigned char* kb, int r32, int hi) {
    const int relmax = U.kpos0 + 64 * t + 63 - U.qpos;
    const bool farb = (relmax <= -128);
    qk_plain<ND0>(n0, n1, kb, qr, U.kc0, r32, hi, farb ? U.tab[0] : 0.f);
    bias_mask(n0, n1, U, t, r32, hi, farb);
    const float rm = rowmax(n0, n1);
    sm.mhat = rm;
#pragma unroll
    for (int r = 0; r < 16; ++r) { n0[r] = __builtin_amdgcn_exp2f(n0[r] - rm); n1[r] = __builtin_amdgcn_exp2f(n1[r] - rm); }
}
template <int ND0>
__device__ __forceinline__ void half_a(int t, const UnitP& U, f32x16& n0, f32x16& n1, const f32x16& pp0, const f32x16& pp1, u32x4 (&pw)[4], SmState& sm, f32x16& negm, float& negc,
                                       const bf16x8 (&qr)[ND0], const ALDS unsigned char* kb, int r32, int hi, float tab0,
                                       bool ahead, const DmaOffs& D, const unsigned char* Kt, const unsigned char* Vt, unsigned kslot, unsigned vslot, int wid) {
    const int relmax = U.kpos0 + 64 * t + 63 - U.qpos;
    const bool farb = (relmax <= -128);
    { const float cin = (farb ? tab0 : 0.f) - sm.mhat;
      if (__any(cin != negc)) { negc = cin;
#pragma unroll
        for (int r = 0; r < 16; ++r) negm[r] = cin;
        APIN(negm); } }
    __builtin_amdgcn_s_setprio(1);
    qk_fill<ND0>(n0, n1, pp0, pp1, pw, sm.l_reg, kb, qr, U.kc0, r32, hi, negm, ahead, D, Kt, Vt, kslot, vslot, wid);
    __builtin_amdgcn_s_setprio(0);
    if (sm.pend) sm.l_reg *= sm.pend_f;
}
__device__ __forceinline__ void half_b(int t, const UnitP& U, f32x16& n0, f32x16& n1, f32x16 (&o)[4], const u32x4 (&pw)[4], SmState& sm, const ALDS unsigned char* vbp, ALDS float* wsf, int r32, int hi) {
    const int relmax = U.kpos0 + 64 * t + 63 - U.qpos;
    bias_mask(n0, n1, U, t, r32, hi, relmax <= -128);
    float ma = -INFINITY, mb = -INFINITY;
    __builtin_amdgcn_s_setprio(1);
    pv_fill<true>(o, pw, vbp, n0, n1, ma, mb);
    __builtin_amdgcn_s_setprio(0);
    if (sm.pend) {
        asm volatile("s_waitcnt lgkmcnt(0)" ::: "memory");
#pragma unroll
        for (int r = 0; r < 16; ++r) { const float fr_ = wsf[crow(r, hi)];
#pragma unroll
            for (int d0 = 0; d0 < 4; ++d0) o[d0][r] *= fr_; }
        sm.pend = false;
    }
    float rm = __builtin_fmaxf(ma, mb);
    { auto rr = __builtin_amdgcn_permlane32_swap(__float_as_uint(rm), __float_as_uint(rm), false, false); rm = __builtin_fmaxf(__uint_as_float(rr[0]), __uint_as_float(rr[1])); }
    if (__any(rm > THR)) {
        const float dl = __builtin_fmaxf(rm, 0.f);
        sm.mhat += dl; sm.pend_f = __builtin_amdgcn_exp2f(-dl); sm.pend = true;
        if (hi == 0) wsf[r32] = sm.pend_f;
    }
}
template <int ND0>
__device__ __forceinline__ void simple_step(int t, bool first, const UnitP& U, f32x16& n0, f32x16& n1, f32x16 (&o)[4], u32x4 (&pw)[4], SmState& sm,
                                            const bf16x8 (&qr)[ND0], const ALDS unsigned char* kb, const ALDS unsigned char* vb, ALDS float* wsf, int r32, int hi) {
    const int relmax = U.kpos0 + 64 * t + 63 - U.qpos;
    const bool farb = (relmax <= -128);
    qk_plain<ND0>(n0, n1, kb, qr, U.kc0, r32, hi, (farb ? U.tab[0] : 0.f) - sm.mhat);
    bias_mask(n0, n1, U, t, r32, hi, farb);
    const float rm = rowmax(n0, n1);
    if (first || __any(rm > THR)) {
        const float dl = first ? rm : __builtin_fmaxf(rm, 0.f);
        sm.mhat += dl;
#pragma unroll
        for (int r = 0; r < 16; ++r) { n0[r] -= dl; n1[r] -= dl; }
        if (!first) {
            const float f = __builtin_amdgcn_exp2f(-dl); sm.l_reg *= f;
            if (hi == 0) wsf[r32] = f;
            asm volatile("s_waitcnt lgkmcnt(0)" ::: "memory");
#pragma unroll
            for (int r = 0; r < 16; ++r) { const float fr_ = wsf[crow(r, hi)];
#pragma unroll
                for (int d0 = 0; d0 < 4; ++d0) o[d0][r] *= fr_; }
        }
    }
#pragma unroll
    for (int r = 0; r < 16; ++r) { n0[r] = __builtin_amdgcn_exp2f(n0[r]); n1[r] = __builtin_amdgcn_exp2f(n1[r]); }
    drain_tile(o, n0, n1, pw, sm.l_reg, vb);
}
__device__ __forceinline__ void bias_half(f32x16& n, const UnitP& U, int t, int r32, int hi, int half) {
    const int base = U.kpos0 + 64 * t - (U.qpos + r32) + 4 * hi + 128 + 32 * half;
#pragma unroll
    for (int r = 0; r < 16; ++r) { int i0 = base + (r & 3) + 8 * (r >> 2); i0 = i0 < 0 ? 0 : (i0 > 191 ? 191 : i0); n[r] += U.tab[i0]; }
    if (half == 1 && t == U.mask_tile) {
#pragma unroll
        for (int r = 0; r < 16; ++r) n[r] = -INFINITY;
    }
}
template <int ND0>
__device__ __forceinline__ void b_step(int t, const UnitP& U, f32x16& p0, f32x16& p1, f32x16 (&o)[4], u32x4 (&pw)[4], SmState& sm,
                                       const bf16x8 (&qr)[ND0], const ALDS unsigned char* kb, const ALDS unsigned char* vb, ALDS float* wsf, int r32, int hi, float tab0) {
    const int relmax = U.kpos0 + 64 * t + 63 - U.qpos;
    const bool farb = (relmax <= -128);
    if (sm.pend) {
        sm.l_reg *= sm.pend_f;
        asm volatile("s_waitcnt lgkmcnt(0)" ::: "memory");
#pragma unroll
        for (int r = 0; r < 16; ++r) { const float fr_ = wsf[crow(r, hi)];
#pragma unroll
            for (int d0 = 0; d0 < 4; ++d0) o[d0][r] *= fr_; }
        sm.pend = false;
    }
    const float cin = (farb ? tab0 : 0.f) - sm.mhat;
#pragma unroll
    for (int r = 0; r < 16; ++r) { p0[r] = cin; p1[r] = cin; }
    float ma = -INFINITY, mb = -INFINITY, sa = 0.f, sb = 0.f;
    {
        bf16x8 kf[2];
        kf[0] = *(const ALDS bf16x8*)(kb + (((U.kc0 + hi) ^ (r32 & 15)) << 4));
        __builtin_amdgcn_s_setprio(1);
#pragma unroll
        for (int d0 = 0; d0 < ND0; ++d0) {
            if (d0 + 1 < ND0) kf[(d0 + 1) & 1] = *(const ALDS bf16x8*)(kb + (((U.kc0 + 2 * (d0 + 1) + hi) ^ (r32 & 15)) << 4));
            ASBAR();
            p0 = __builtin_amdgcn_mfma_f32_32x32x16_bf16(kf[d0 & 1], qr[d0], p0, 0, 0, 0);
            ASBAR();
        }
        __builtin_amdgcn_s_setprio(0);
    }
    if (!farb) bias_half(p0, U, t, r32, hi, 0);
    {
        bf16x8 kf[2];
        kf[0] = *(const ALDS bf16x8*)(kb + 8192 + (((U.kc0 + hi) ^ (r32 & 15)) << 4));
        __builtin_amdgcn_s_setprio(1);
#pragma unroll
        for (int d0 = 0; d0 < ND0; ++d0) {
            if (d0 + 1 < ND0) kf[(d0 + 1) & 1] = *(const ALDS bf16x8*)(kb + 8192 + (((U.kc0 + 2 * (d0 + 1) + hi) ^ (r32 & 15)) << 4));
            ASBAR();
            p1 = __builtin_amdgcn_mfma_f32_32x32x16_bf16(kf[d0 & 1], qr[d0], p1, 0, 0, 0);
            { const int e = 2 * d0;
              if (d0 & 1) mb = AMX3(mb, p0[e], p0[e + 1]); else ma = AMX3(ma, p0[e], p0[e + 1]);
              p0[e] = __builtin_amdgcn_exp2f(p0[e]); p0[e + 1] = __builtin_amdgcn_exp2f(p0[e + 1]);
              sa += p0[e]; sb += p0[e + 1];
              pw[d0 >> 2][d0 & 3] = cvtpk(p0[e], p0[e + 1]);
              APIN(p0); APIN(sa); APIN(sb); APIN(pw[d0 >> 2]); if (d0 & 1) APIN(mb); else APIN(ma); }
            ASBAR();
        }
        __builtin_amdgcn_s_setprio(0);
    }
    if (!farb) bias_half(p1, U, t, r32, hi, 1);
    {
        s16x4 lo[2], hh[2];
        lo[0] = vtr(vb); hh[0] = vtr(vb + 512);
        __builtin_amdgcn_s_setprio(1);
#pragma unroll
        for (int i = 0; i < 16; ++i) {
            const int d0 = (i & 7) >> 1, ks = (i & 1) + 2 * (i >> 3);
            if (i + 1 < 16) { const int d1 = ((i + 1) & 7) >> 1, k1 = ((i + 1) & 1) + 2 * ((i + 1) >> 3); lo[(i + 1) & 1] = vtr(vb + d1 * 4096 + k1 * 1024); hh[(i + 1) & 1] = vtr(vb + d1 * 4096 + k1 * 1024 + 512); }
            ASBAR();
            const s16x4 l_ = lo[i & 1], h_ = hh[i & 1];
            const bf16x8 vf = (bf16x8){l_[0], l_[1], l_[2], l_[3], h_[0], h_[1], h_[2], h_[3]};
            o[d0] = __builtin_amdgcn_mfma_f32_32x32x16_bf16(__builtin_bit_cast(bf16x8, pw[ks]), vf, o[d0], 0, 0, 0);
            if (i < 8) { const int e = 2 * i;
              if (i & 1) mb = AMX3(mb, p1[e], p1[e + 1]); else ma = AMX3(ma, p1[e], p1[e + 1]);
              p1[e] = __builtin_amdgcn_exp2f(p1[e]); p1[e + 1] = __builtin_amdgcn_exp2f(p1[e + 1]);
              sa += p1[e]; sb += p1[e + 1];
              pw[2 + (i >> 2)][i & 3] = cvtpk(p1[e], p1[e + 1]);
              APIN(p1); APIN(sa); APIN(sb); APIN(pw[2 + (i >> 2)]); if (i & 1) APIN(mb); else APIN(ma); }
            ASBAR();
        }
        __builtin_amdgcn_s_setprio(0);
    }
    sm.l_reg += sa + sb;
    float rm = __builtin_fmaxf(ma, mb);
    { auto rr = __builtin_amdgcn_permlane32_swap(__float_as_uint(rm), __float_as_uint(rm), false, false); rm = __builtin_fmaxf(__uint_as_float(rr[0]), __uint_as_float(rr[1])); }
    if (__any(rm > THR)) {
        const float dl = __builtin_fmaxf(rm, 0.f);
        sm.mhat += dl; sm.pend_f = __builtin_amdgcn_exp2f(-dl); sm.pend = true;
        if (hi == 0) wsf[r32] = sm.pend_f;
    }
}
__device__ __forceinline__ void store_block(const f32x16 (&v)[4], ALDS float* stage, const unsigned char* ws, unsigned zoff, unsigned ooff, int row0, int hcol, int lane, int r32, int hi) {
    u32x4 zz[8];
#pragma unroll
    for (int i = 0; i < 8; ++i) { const int idx = i * 64 + lane, row = idx >> 4, g = idx & 15;
        zz[i] = *(const u32x4*)(ws + zoff + (unsigned)((row0 + row) * PITCH + hcol + g * 8) * 2u); }
    asm volatile("" ::: "memory");
#pragma unroll
    for (int d0 = 0; d0 < 4; ++d0)
#pragma unroll
        for (int r = 0; r < 16; ++r) stage[crow(r, hi) * 128 + 32 * d0 + r32] = v[d0][r];
    asm volatile("s_waitcnt lgkmcnt(0)" ::: "memory");
#pragma unroll
    for (int i = 0; i < 8; ++i) {
        const int idx = i * 64 + lane, row = idx >> 4, g = idx & 15;
        const f32x4_t a0 = *(const ALDS f32x4_t*)(stage + row * 128 + g * 8), a1 = *(const ALDS f32x4_t*)(stage + row * 128 + g * 8 + 4);
        const unsigned off = (unsigned)((row0 + row) * PITCH + hcol + g * 8) * 2u;
        const u32x4 z = zz[i];
        u32x4 w;
        w[0] = cvtpk(a0[0] * __builtin_bit_cast(float, z[0] << 16), a0[1] * __builtin_bit_cast(float, z[0] & 0xffff0000u));
        w[1] = cvtpk(a0[2] * __builtin_bit_cast(float, z[1] << 16), a0[3] * __builtin_bit_cast(float, z[1] & 0xffff0000u));
        w[2] = cvtpk(a1[0] * __builtin_bit_cast(float, z[2] << 16), a1[1] * __builtin_bit_cast(float, z[2] & 0xffff0000u));
        w[3] = cvtpk(a1[2] * __builtin_bit_cast(float, z[3] << 16), a1[3] * __builtin_bit_cast(float, z[3] & 0xffff0000u));
        *(u32x4*)(const_cast<unsigned char*>(ws) + ooff + off) = w;
    }
}
template <int KIND>
__device__ __forceinline__ void attn_unit(const UnitP& U, const unsigned char* ws, ALDS unsigned char* lds, ALDS float* wsf, float lam, const float* subg) {
    constexpr int ND0 = (KIND == 0) ? 4 : 8;
    int tid_ = threadIdx.x; asm volatile("" : "+v"(tid_));
    const int tid = tid_, lane = tid & 63, r32 = lane & 31, hi = lane >> 5; const int wid = __builtin_amdgcn_readfirstlane(tid >> 6);
    const bool active = U.vis_lo <= U.vis_hi;
    const DmaOffs D = dma_offsets(wid, lane);
    const unsigned char* const Kg = ws + U.koff; const unsigned char* const Vg = ws + U.voff;
    constexpr size_t TSTR = (size_t)64 * PITCH * 2;
    const unsigned lds0 = (unsigned)(uintptr_t)lds;
    dma_tile(D, Kg + (size_t)U.t_begin * TSTR, Vg + (size_t)U.t_begin * TSTR, lds0 + L_K, lds0 + L_V, wid);
    if (U.t_begin + 1 < U.t_end) dma_tile(D, Kg + (size_t)(U.t_begin + 1) * TSTR, Vg + (size_t)(U.t_begin + 1) * TSTR, lds0 + L_K + TILE_B, lds0 + L_V + TILE_B, wid);
    bf16x8 qr[ND0];
#pragma unroll
    for (int d0 = 0; d0 < ND0; ++d0) qr[d0] = *(const bf16x8*)(ws + U.qoff + (unsigned)(r32 * PITCH + d0 * 16 + hi * 8) * 2u);
    f32x16 o[4];
#pragma unroll
    for (int d0 = 0; d0 < 4; ++d0) o[d0] = f32x16{};
    SmState sm; sm.mhat = 0.f; sm.l_reg = 0.f; sm.pend_f = 1.f; sm.pend = false;
    asm volatile("s_waitcnt vmcnt(0)" ::: "memory");
#pragma unroll
    for (int d0 = 0; d0 < ND0; ++d0) asm volatile("" : "+v"(qr[d0]));
    __builtin_amdgcn_s_barrier();
    const int vbo = ((lane >> 4) & 1) * 32 + (lane & 3) * 8 + (4 * hi + ((lane & 15) >> 2)) * 64;
    const float tab0 = U.tab[0];
    int kcur = 0, vcur = 0, vprev = 0, vprev2 = 0;
    const int tf = active ? ((U.vis_lo > U.t_begin) ? U.vis_lo : U.t_begin) : U.t_end, tl = active ? U.vis_hi : U.t_end;
#define ATT_KB (lds + L_K + kcur * TILE_B + r32 * 256)
#define ATT_VBP (lds + L_V + vprev * TILE_B + vbo)
#define ATT_SLOTK (lds0 + L_K + ((kcur >= 1) ? kcur - 1 : 2) * TILE_B)
#define ATT_SLOTV (lds0 + L_V + ((vcur >= 3) ? vcur - 3 : vcur + 2) * TILE_B)
#define ATT_VBP2 (lds + L_V + vprev2 * TILE_B + vbo)
#define ATT_TAIL(ahead_) do { \
        if (ahead_) asm volatile("s_waitcnt vmcnt(4)" ::: "memory"); else asm volatile("s_waitcnt vmcnt(0)" ::: "memory"); \
        asm volatile("s_waitcnt lgkmcnt(0)" ::: "memory"); \
        __builtin_amdgcn_s_barrier(); \
        kcur = (kcur == 2) ? 0 : kcur + 1; vprev2 = vprev; vprev = vcur; vcur = (vcur == 4) ? 0 : vcur + 1; \
    } while (0)
#define ATT_ITER(tt, BODY) do { \
        const bool ahead_ = ((tt) + 2 < U.t_end); \
        if (ahead_) dma_tile(D, Kg + (size_t)((tt) + 2) * TSTR, Vg + (size_t)((tt) + 2) * TSTR, ATT_SLOTK, ATT_SLOTV, wid); \
        BODY; \
        ATT_TAIL(ahead_); \
    } while (0)
#define ATT_HA(tt, N0, N1, P0, P1) half_a<ND0>((tt), U, N0, N1, P0, P1, pw, sm, negm, negc, qr, ATT_KB, r32, hi, tab0, ahead_, D, Kg + (size_t)((tt) + 2) * TSTR, Vg + (size_t)((tt) + 2) * TSTR, ATT_SLOTK, ATT_SLOTV, wid)
#define ATT_FULL(tt, N0, N1, P0, P1) do {     \
        const bool ahead_ = ((tt) + 2 < U.t_end); \
        ATT_HA(tt, N0, N1, P0, P1); \
        half_b((tt), U, N0, N1, o, pw, sm, ATT_VBP, wsf, r32, hi); \
        ATT_TAIL(ahead_); \
    } while (0)
#define ATT_G2F(tt, N0, N1, P0, P1) do {      \
        const bool ahead_ = ((tt) + 2 < U.t_end); \
        ATT_HA(tt, N0, N1, P0, P1); \
        ATT_TAIL(ahead_); \
        half_b((tt), U, N0, N1, o, pw, sm, ATT_VBP2, wsf, r32, hi); \
    } while (0)
    int t = U.t_begin;
    for (; t < tf; ++t) ATT_ITER(t, (void)0);
    if (active) {
        if (KIND == 0 && wid < 4) {
            u32x4 pw[4]; f32x16 sA0, sA1, sB0, sB1; f32x16 negm = f32x16{}; float negc = 0.f;
            ATT_ITER(t, first_step<ND0>(t, U, sB0, sB1, sm, qr, ATT_KB, r32, hi)); ++t;
            for (; t + 1 <= tl; t += 2) {
                ATT_FULL(t, sA0, sA1, sB0, sB1);
                ATT_FULL(t + 1, sB0, sB1, sA0, sA1);
            }
            if (t <= tl) {
                ATT_FULL(t, sA0, sA1, sB0, sB1); ++t;
                sB0 = sA0; sB1 = sA1;
            }
            if (t < U.t_end) { ATT_ITER(t, drain_tile(o, sB0, sB1, pw, sm.l_reg, ATT_VBP)); ++t; }
            else drain_tile(o, sB0, sB1, pw, sm.l_reg, ATT_VBP);
        } else if (KIND == 0) {
            u32x4 pw[4]; f32x16 sA0, sA1, sB0, sB1; f32x16 negm = f32x16{}; float negc = 0.f;
            ATT_ITER(t, first_step<ND0>(t, U, sB0, sB1, sm, qr, ATT_KB, r32, hi)); ++t;
            for (; t + 1 <= tl; t += 2) {
                ATT_G2F(t, sA0, sA1, sB0, sB1);
                ATT_G2F(t + 1, sB0, sB1, sA0, sA1);
            }
            if (t <= tl) {
                ATT_G2F(t, sA0, sA1, sB0, sB1); ++t;
                sB0 = sA0; sB1 = sA1;
            }
            if (t < U.t_end) { ATT_ITER(t, drain_tile(o, sB0, sB1, pw, sm.l_reg, ATT_VBP)); ++t; }
            else drain_tile(o, sB0, sB1, pw, sm.l_reg, ATT_VBP);
        } else {
            u32x4 pw[4]; f32x16 sB0, sB1;
            ATT_ITER(t, simple_step<ND0>(t, true, U, sB0, sB1, o, pw, sm, qr, ATT_KB, lds + L_V + vcur * TILE_B + vbo, wsf, r32, hi)); ++t;
            for (; t <= tl; ++t) ATT_ITER(t, b_step<ND0>(t, U, sB0, sB1, o, pw, sm, qr, ATT_KB, lds + L_V + vcur * TILE_B + vbo, wsf, r32, hi, tab0));
        }
    }
    for (; t < U.t_end; ++t) ATT_ITER(t, (void)0);
#undef ATT_ITER
#undef ATT_FULL
#undef ATT_G2F
#undef ATT_HA
#undef ATT_TAIL
#undef ATT_SLOTK
#undef ATT_SLOTV
#undef ATT_VBP2
#undef ATT_KB
#undef ATT_VBP
    float l_reg = sm.l_reg;
    { auto rr = __builtin_amdgcn_permlane32_swap(__float_as_uint(l_reg), __float_as_uint(l_reg), false, false); l_reg = __uint_as_float(rr[0]) + __uint_as_float(rr[1]); }
    if (hi == 0) wsf[32 + r32] = l_reg;
    asm volatile("s_waitcnt lgkmcnt(0)" ::: "memory");
    float rli[16];
#pragma unroll
    for (int r = 0; r < 16; ++r) rli[r] = __builtin_amdgcn_rcpf(wsf[32 + crow(r, hi)]);
    if (KIND == 0) {
        ALDS float* xch = (ALDS float*)(lds + L_XCH);
        __syncthreads();
        if (wid >= 4 && active) {
#pragma unroll
            for (int d0 = 0; d0 < 4; ++d0)
#pragma unroll
                for (int r = 0; r < 16; ++r) xch[((U.xslot * 4 + d0) * 16 + r) * 64 + lane] = o[d0][r] * rli[r];
        }
        __syncthreads();
        if (wid < 4 && active) {
            float ss[16];
#pragma unroll
            for (int r = 0; r < 16; ++r) ss[r] = 0.f;
#pragma unroll
            for (int d0 = 0; d0 < 4; ++d0)
#pragma unroll
                for (int r = 0; r < 16; ++r) { const float x = o[d0][r] * rli[r] - lam * xch[((U.xslot * 4 + d0) * 16 + r) * 64 + lane]; o[d0][r] = x; ss[r] += x * x; }
#pragma unroll
            for (int r = 0; r < 16; ++r) {
                float s = ss[r];
                s += __shfl_xor(s, 1); s += __shfl_xor(s, 2); s += __shfl_xor(s, 4); s += __shfl_xor(s, 8); s += __shfl_xor(s, 16);
                ss[r] = __builtin_amdgcn_rsqf(s * (1.0f / 128.0f) + 1e-6f) * 0.8f;
            }
#pragma unroll
            for (int d0 = 0; d0 < 4; ++d0) {
                const float sg = subg[32 * d0 + r32];
#pragma unroll
                for (int r = 0; r < 16; ++r) o[d0][r] = o[d0][r] * ss[r] * sg;
            }
            asm volatile("s_waitcnt lgkmcnt(0)" ::: "memory");
            store_block(o, xch + U.xslot * 4096, ws, U.zoff, U.ooff, U.out_row0, U.hcol, lane, r32, hi);
        }
        __syncthreads();
    } else {
        if (active) {
#pragma unroll
            for (int d0 = 0; d0 < 4; ++d0)
#pragma unroll
                for (int r = 0; r < 16; ++r) o[d0][r] *= rli[r];
            store_block(o, (ALDS float*)(lds + wid * 16384), ws, U.zoff, U.ooff, U.out_row0, U.hcol, lane, r32, hi);
        }
    }
}
}
#define GAS __attribute__((address_space(1)))
#define LAS __attribute__((address_space(3)))
typedef unsigned short bf16;
typedef unsigned v4u __attribute__((ext_vector_type(4)));
typedef float f32x4 __attribute__((ext_vector_type(4)));
typedef short bf16x8 __attribute__((ext_vector_type(8)));
typedef GAS unsigned gu32;
typedef GAS unsigned long long gu64;
#define RLX_AGENT __ATOMIC_RELAXED, __HIP_MEMORY_SCOPE_AGENT
#define LDS_WAIT() asm volatile("s_waitcnt lgkmcnt(0)" ::: "memory")
#define VM_WAIT() asm volatile("s_waitcnt vmcnt(0)" ::: "memory")
__device__ __forceinline__ unsigned long long rt() { return __builtin_amdgcn_s_memrealtime(); }
__device__ __forceinline__ unsigned f2bf(float f) { unsigned u = __builtin_bit_cast(unsigned, f); return (u + 0x7fffu + ((u >> 16) & 1u)) >> 16; }
typedef float fp_f32x2 __attribute__((ext_vector_type(2)));
typedef __bf16 fp_bf16x2 __attribute__((ext_vector_type(2)));
__device__ __forceinline__ unsigned pk2(float lo, float hi) { fp_f32x2 v = {lo, hi}; fp_bf16x2 b = __builtin_convertvector(v, fp_bf16x2); return __builtin_bit_cast(unsigned, b); }
#define XB_TMO      128
#define XB_XCNT(j)  (256  + 64 * (j))
#define XB_XSUB(j)  (1280 + 64 * (j))
#define XB_XGEN(j)  (2304 + 64 * (j))
#define XB_TOP      3328
#define XB_TOPGEN   3392
#define XCD_BAR_WORDS 3456
#define XB_SPIN_CAP (1u << 18)

__device__ __forceinline__ unsigned xb_ld(unsigned* p)              { return __hip_atomic_load(p, __ATOMIC_RELAXED, __HIP_MEMORY_SCOPE_AGENT); }
__device__ __forceinline__ unsigned xb_add(unsigned* p, unsigned v) { return __hip_atomic_fetch_add(p, v, __ATOMIC_RELAXED, __HIP_MEMORY_SCOPE_AGENT); }
__device__ __forceinline__ unsigned xb_xcc_id() { return (unsigned)__builtin_amdgcn_s_getreg((3 << 11) | 20) & 0xFu; }
#define XB_SPIN(cond, bar) do { unsigned _sp = 0; while (cond) { __builtin_amdgcn_s_sleep(1); \
    if ((++_sp & 255u) == 0u) { if (xb_ld(&(bar)[XB_TMO])) break; if (_sp > XB_SPIN_CAP) { atomicAdd(&(bar)[XB_TMO], 1u); break; } } } } while (0)

struct XcdBarrier {
    unsigned* bar; unsigned x;
    volatile LAS unsigned* st;
};

__device__ __forceinline__ XcdBarrier xcd_barrier_post(unsigned* bar, volatile LAS unsigned* st) {
    XcdBarrier b; b.bar = bar; b.x = xb_xcc_id(); b.st = st;
    if (threadIdx.x == 0) (void)xb_add(&bar[XB_XCNT(b.x)], 1u);
    return b;
}
__device__ __forceinline__ void xcd_barrier_complete(unsigned* bar, unsigned x, unsigned& nloc, unsigned& nx) {
    const unsigned G = gridDim.x * gridDim.y * gridDim.z;
    unsigned sum, cnt, mine, sp = 0u;
    for (;;) {
        sum = 0u; cnt = 0u; mine = 0u;
#pragma unroll
        for (unsigned j = 0; j < 16; ++j) { const unsigned c = xb_ld(&bar[XB_XCNT(j)]); sum += c; cnt += (c > 0u) ? 1u : 0u; mine = (j == x) ? c : mine; }
        if (sum == G) break;
        __builtin_amdgcn_s_sleep(1);
        if ((++sp & 255u) == 0u) { if (xb_ld(&bar[XB_TMO])) break; if (sp > XB_SPIN_CAP) { atomicAdd(&bar[XB_TMO], 1u); break; } }
    }
    nloc = mine > 0u ? mine : 1u; nx = cnt > 0u ? cnt : 1u;
}

__device__ __forceinline__ void xcd_barrier(const XcdBarrier& b) {
    asm volatile("s_waitcnt vmcnt(0)" ::: "memory");
    __syncthreads();
    if (threadIdx.x == 0) {
        unsigned* bar = b.bar;
        __builtin_amdgcn_s_waitcnt(0);
        unsigned nloc = b.st[0], nx = b.st[1];
        if (nloc == 0u) { xcd_barrier_complete(bar, b.x, nloc, nx); b.st[0] = nloc; b.st[1] = nx; }
        const unsigned old = xb_add(&bar[XB_XSUB(b.x)], 1u);
        const unsigned gen = old / nloc;
        if (old + 1u == (gen + 1u) * nloc) {
            __builtin_amdgcn_fence(__ATOMIC_RELEASE, "agent");
            asm volatile("s_waitcnt vmcnt(0)" ::: "memory");
            const unsigned og = xb_add(&bar[XB_TOP], 1u);
            const unsigned tg = og / nx;
            if (og + 1u == (tg + 1u) * nx) xb_add(&bar[XB_TOPGEN], 1u);
            else XB_SPIN(xb_ld(&bar[XB_TOPGEN]) == tg, bar);
            __builtin_amdgcn_fence(__ATOMIC_ACQUIRE, "agent");
            xb_add(&bar[XB_XGEN(b.x)], 1u);
            asm volatile("s_waitcnt vmcnt(0)" ::: "memory");
        } else {
            XB_SPIN(xb_ld(&bar[XB_XGEN(b.x)]) == gen, bar);
            __builtin_amdgcn_fence(__ATOMIC_ACQUIRE, "agent");
            asm volatile("s_waitcnt vmcnt(0)" ::: "memory");
        }
    }
    __syncthreads();
}

struct Frame {
    LAS unsigned char* lds; volatile LAS unsigned* MISC; gu32* ctl;
    int tid, lane, wave, vcu, G;
};
__device__ __forceinline__ float wave_sum(float v) {
#pragma unroll
    for (int o = 1; o < 64; o <<= 1) v += __shfl_xor(v, o);
    return v;
}
__device__ __forceinline__ void p0_transpose_item(const float* W, int K, int N, bf16* WT, int row_off, LAS float* scr, int item, int lane) {
    const int nblk = N / 32, kb = item / nblk, nb = item % nblk, k0 = 64 * kb, n0 = 32 * nb;
    f32x4 v[8];
#pragma unroll
    for (int i = 0; i < 8; ++i) v[i] = __builtin_nontemporal_load((const GAS f32x4*)(W + (size_t)(k0 + 8 * i + (lane >> 3)) * N + n0 + 4 * (lane & 7)));
#pragma unroll
    for (int i = 0; i < 8; ++i) *(LAS f32x4*)(scr + (8 * i + (lane >> 3)) * 36 + 4 * (lane & 7)) = v[i];
    LDS_WAIT(); asm volatile("" ::: "memory");
    const int c = lane & 7;
#pragma unroll
    for (int j = 0; j < 4; ++j) { const int n = (lane >> 3) + 8 * j; const LAS float* s = scr + (8 * c) * 36 + n;
        v4u o; o.x = pk2(s[0 * 36], s[1 * 36]); o.y = pk2(s[2 * 36], s[3 * 36]); o.z = pk2(s[4 * 36], s[5 * 36]); o.w = pk2(s[6 * 36], s[7 * 36]);
        *(GAS v4u*)(WT + (size_t)(row_off + n0 + n) * K + k0 + 8 * c) = o; }
    LDS_WAIT(); asm volatile("" ::: "memory");
}
__device__ __forceinline__ v4u pair16(unsigned a0, unsigned a1, unsigned b0, unsigned b1, bool odd) {
    const unsigned s0 = odd ? a0 : b0, s1 = odd ? a1 : b1;
    const unsigned r0 = (unsigned)__builtin_amdgcn_mov_dpp((int)s0, 0xB1, 0xF, 0xF, true), r1 = (unsigned)__builtin_amdgcn_mov_dpp((int)s1, 0xB1, 0xF, 0xF, true);
    v4u o; o.x = odd ? r0 : a0; o.y = odd ? r1 : a1; o.z = odd ? b0 : r0; o.w = odd ? b1 : r1; return o;
}
__device__ __forceinline__ void rms_row_to_bf16(const float* xrow, const float* g, bf16* orow, int lane) {
    const GAS f32x4* xr = (const GAS f32x4*)xrow + lane; const GAS f32x4* gr = (const GAS f32x4*)g + lane;
    f32x4 v[8]; float s = 0.f;
#pragma unroll
    for (int j = 0; j < 8; ++j) { v[j] = __builtin_nontemporal_load(xr + 64 * j); s += (v[j].x * v[j].x + v[j].y * v[j].y) + (v[j].z * v[j].z + v[j].w * v[j].w); }
    const float rstd = 1.0f / sqrtf(wave_sum(s) * (1.f / 2048.f) + 1e-6f);
    const bool odd = lane & 1; GAS v4u* o16 = (GAS v4u*)(orow + (odd ? 256 : 0) + 8 * (lane >> 1));
#pragma unroll
    for (int j = 0; j < 8; j += 2) { const f32x4 ga = gr[64 * j], gb = gr[64 * j + 64];
        o16[32 * j] = pair16(pk2(v[j].x * rstd * ga.x, v[j].y * rstd * ga.y), pk2(v[j].z * rstd * ga.z, v[j].w * rstd * ga.w),
                             pk2(v[j + 1].x * rstd * gb.x, v[j + 1].y * rstd * gb.y), pk2(v[j + 1].z * rstd * gb.z, v[j + 1].w * rstd * gb.w), odd); }
}
template <int NL>
__device__ __forceinline__ void cvt_rows_1024(const float* src, bf16* dst, float* fcopy, int lane) {
    const GAS f32x4* xr = (const GAS f32x4*)src + lane; const bool odd = lane & 1; GAS v4u* o16 = (GAS v4u*)(dst + (odd ? 256 : 0) + 8 * (lane >> 1));
    f32x4 v[NL];
#pragma unroll
    for (int j = 0; j < NL; ++j) v[j] = __builtin_nontemporal_load(xr + 64 * j);
#pragma unroll
    for (int j = 0; j < NL; j += 2) {
        __builtin_nontemporal_store(pair16(pk2(v[j].x, v[j].y), pk2(v[j].z, v[j].w), pk2(v[j + 1].x, v[j + 1].y), pk2(v[j + 1].z, v[j + 1].w), odd), o16 + 32 * j);
        if (fcopy) { __builtin_nontemporal_store(v[j], (GAS f32x4*)fcopy + lane + 64 * j); __builtin_nontemporal_store(v[j + 1], (GAS f32x4*)fcopy + lane + 64 * j + 64); } }
}
__device__ __forceinline__ void zero_row_1024(bf16* dst, int lane) {
    GAS unsigned long long* o8 = (GAS unsigned long long*)dst + lane;
#pragma unroll
    for (int j = 0; j < 4; ++j) o8[64 * j] = 0ull;
}

__device__ __forceinline__ void item_done(gu32* ctr) {
    asm volatile("s_waitcnt vmcnt(0)" ::: "memory");
    __syncthreads();
    if (__builtin_amdgcn_readfirstlane(threadIdx.x >> 6) == 0) {
        if ((threadIdx.x & 63) == 0) {
            __builtin_amdgcn_fence(__ATOMIC_RELEASE, "agent");
            asm volatile("s_waitcnt vmcnt(0)" ::: "memory");
            __hip_atomic_fetch_add(ctr, 1u, RLX_AGENT);
        }
    }
}
__device__ __forceinline__ void item_wait(gu32* ctr, unsigned need, gu32* tmo) {
    if (__builtin_amdgcn_readfirstlane(threadIdx.x >> 6) == 0) {
      if ((threadIdx.x & 63) == 0) {
        unsigned sp = 0;
        while (__hip_atomic_load(ctr, RLX_AGENT) < need) {
            __builtin_amdgcn_s_sleep(8);
            if ((++sp & 1023u) == 0u) { if (__hip_atomic_load(tmo, RLX_AGENT) != 0u) break; if (sp > (1u << 20)) { __hip_atomic_store(tmo, 1u, RLX_AGENT); break; } }
        }
        __builtin_amdgcn_fence(__ATOMIC_ACQUIRE, "agent");
        asm volatile("s_waitcnt vmcnt(0)" ::: "memory");
      }
    }
    __syncthreads();
}

#if PROBE_MULT
#define TS(n) do { if (blockIdx.x == 0 && F.wave == 0) { if (F.lane == 0) { const unsigned long long t_ = wall_clock64(); F.ctl[2048 + 2 * (n)] = (unsigned)t_; F.ctl[2048 + 2 * (n) + 1] = (unsigned)(t_ >> 32); const unsigned long long c_ = __builtin_amdgcn_s_memtime(); F.ctl[2112 + 2 * (n)] = (unsigned)c_; F.ctl[2112 + 2 * (n) + 1] = (unsigned)(c_ >> 32); } } } while (0)
#else
#define TS(n) do { } while (0)
#endif
struct Args { const float* in[19]; float* out; unsigned char* ws; int pad0, pad1; };

__global__ void __launch_bounds__(NWAVES * 64, 2) fwd_kernel(Args args) {
    extern __shared__ __attribute__((aligned(16))) unsigned char lds[];
    Frame F;
    F.lds = (LAS unsigned char*)lds; F.MISC = (volatile LAS unsigned*)(F.lds + MISC_OFF);
    F.tid = threadIdx.x; F.lane = F.tid & 63; F.wave = __builtin_amdgcn_readfirstlane(F.tid >> 6);
    F.G = gridDim.x; { const int bx = blockIdx.x; F.vcu = (F.G % 8 == 0) ? (bx % 8) * (F.G / 8) + bx / 8 : bx; }
    unsigned char* ws = args.ws; float* out = args.out;
    F.ctl = (gu32*)(ws + WS_CTL);
    if (F.tid < 64) ((LAS unsigned*)(F.lds + MISC_OFF))[F.tid] = 0u;
    __syncthreads();
    XcdBarrier bar = xcd_barrier_post((unsigned*)(F.ctl + CW_BAR), F.MISC + 8);

    const int gw = F.vcu * NWAVES + F.wave, NGW = F.G * NWAVES;
    {
        const float* t5_bias = args.in[6]; const float* lq1 = args.in[10]; const float* lk1 = args.in[11]; const float* lq2 = args.in[12]; const float* lk2 = args.in[13];
        const float* rel_bias_b = args.in[15];
        LAS float* tab = (LAS float*)(F.lds + TAB_OFF);
        for (int i = F.tid; i < 8 * 192; i += NWAVES * 64) {
            const int h = i / 192, idx = i % 192, rel = idx - 128;
            const int n = rel < 0 ? -rel : rel; int bkt;
            if (n < 8) bkt = n; else { const int k = (31 - __builtin_clz((unsigned)(n * n))) - 6; bkt = 8 + k; if (bkt > 15) bkt = 15; }
            if (rel > 0) bkt += 16;
            tab[i] = t5_bias[bkt * 8 + h] * LOG2E;
            tab[8 * 192 + i] = rel_bias_b[h * 257 + idx] * LOG2E;
        }
        float s1 = lq1[F.lane] * lk1[F.lane], s2 = lq2[F.lane] * lk2[F.lane];
        s1 = wave_sum(s1); s2 = wave_sum(s2);
        const float lam0 = expf(s1) - expf(s2) + 0.2f;
        if (F.tid == 0) F.MISC[20] = __builtin_bit_cast(unsigned, lam0);
    }
    TS(0);

    for (int rep = 0; rep < REP_P0; ++rep) {
        const float* x_prompt = args.in[0]; const float* x_sample = args.in[1]; const float* pre_norm = args.in[7]; const float* w_in = args.in[9];
        bf16* WinT = (bf16*)(ws + WS_WINT); bf16* XN = (bf16*)(ws + WS_XN);
        LAS float* scr = (LAS float*)(F.lds + RING_OFF + F.wave * 16384);
        int lane0 = threadIdx.x & 63; asm volatile("" : "+v"(lane0));
        constexpr int I_IN = (DM / 64) * (NIN / 32);
        for (int it = gw; it < I_IN; it += NGW) p0_transpose_item(w_in, DM, NIN, WinT, 0, scr, it, lane0);
        for (int m = gw; m < MT; m += NGW) rms_row_to_bf16(m < SEQ ? x_prompt + (size_t)m * DM : x_sample + (size_t)(m - SEQ) * DM, pre_norm, XN + (size_t)m * DM, lane0);
    }
    xcd_barrier(bar);
    TS(1);

    {
        const int tiles = (MT / 256) * (NIN / 256), rounds = (tiles + F.G - 1) / F.G; int nG = (((tiles + rounds - 1) / rounds) + 7) & ~7; if (nG > F.G) nG = F.G;
        if ((int)blockIdx.x < nG) for (int rep = 0; rep < REP_P1; ++rep) {
            pg8::Gemm g{(const bf16*)(ws + WS_XN), (const bf16*)(ws + WS_WINT), MT, NIN, DM}; pg8::StaticOrder S; S.init(MT, NIN, nG, (int)blockIdx.x);
            pg8::EpiInProj E{ws, out};
            pg8::gemm_phase<pg8::EpiInProj, pg8::StaticOrder, true, true>(F.lds + RING_OFF, g, S, E);
        }
        TS(6);
        {
            const float* cache_k_a = args.in[2]; const float* cache_v_a = args.in[3]; const float* cache_k_b = args.in[4]; const float* cache_v_b = args.in[5];
            const float* w_o_a = args.in[16]; const float* w_o_b = args.in[17]; const float* w_out = args.in[18];
            bf16* WoT = (bf16*)(ws + WS_WOT); bf16* WoutT = (bf16*)(ws + WS_WOUTT);
            bf16 *KAs = (bf16*)(ws + WS_KAS), *VAs = (bf16*)(ws + WS_VAS), *KBs = (bf16*)(ws + WS_KBS), *VBs = (bf16*)(ws + WS_VBS);
            LAS float* scr = (LAS float*)(F.lds + RING_OFF + F.wave * 16384);
            int lane1 = threadIdx.x & 63; asm volatile("" : "+v"(lane1));
            constexpr int I_OA = (1024 / 64) * (DM / 32), I_OUT = (DM / 64) * (DM / 32);
            constexpr int N_CA = 2 * 8 * (PAST / 8), N_CB = 2 * 8 * 64, N_PAD = 4 * 8 * 32, N_TR = 2 * I_OA + I_OUT, N_SIDE = N_CA + N_CB + N_PAD + N_TR;
            for (;;) {
                unsigned base = 0;
                if (lane1 == 0) base = __hip_atomic_fetch_add(F.ctl + CW_SIDE, (unsigned)SIDE_BATCH, RLX_AGENT);
                base = (unsigned)__builtin_amdgcn_readfirstlane((int)base);
                if (base >= (unsigned)N_SIDE) break;
                const int iend = ((int)base + SIDE_BATCH < N_SIDE) ? (int)base + SIDE_BATCH : N_SIDE;
                for (int it = (int)base; it < iend; ++it) {
                    int m = it;
                    if (m < N_CA) {
                        const int which = m / (8 * (PAST / 8)), rr = (m % (8 * (PAST / 8))) * 8, b = rr / PAST, r = rr % PAST;
                        cvt_rows_1024<32>((which ? cache_v_a : cache_k_a) + (size_t)rr * 1024, (which ? VAs : KAs) + ((size_t)b * KAS_ROWS + r) * 1024, nullptr, lane1); continue; }
                    m -= N_CA;
                    if (m < N_CB) {
                        const int which = m / (8 * 64), rr = (m % (8 * 64)) * 8, b = rr / 512, r = rr % 512;
                        float* fc = (r >= 32) ? out + (which ? O_VBS : O_KBS) + ((size_t)b * 512 + (r - 32)) * 1024 : nullptr;
                        cvt_rows_1024<32>((which ? cache_v_b : cache_k_b) + (size_t)rr * 1024, (which ? VBs : KBs) + ((size_t)b * KBS_ROWS + r) * 1024, fc, lane1); continue; }
                    m -= N_CB;
                    if (m < N_PAD) {
                        const int which = m / 256, rr = m % 256, b = rr / 32, r = rr % 32;
                        bf16* d = which == 0 ? KAs + ((size_t)b * KAS_ROWS + PAST + 32 + r) * 1024 : which == 1 ? VAs + ((size_t)b * KAS_ROWS + PAST + 32 + r) * 1024
                                : which == 2 ? KBs + ((size_t)b * KBS_ROWS + 544 + r) * 1024 : VBs + ((size_t)b * KBS_ROWS + 544 + r) * 1024;
                        zero_row_1024(d, lane1); continue; }
                    m -= N_PAD;
                    if (m < I_OA) { p0_transpose_item(w_o_a, 1024, DM, WoT, 0, scr, m, lane1); continue; } m -= I_OA;
                    if (m < I_OA) { p0_transpose_item(w_o_b, 1024, DM, WoT, 2048, scr, m, lane1); continue; } m -= I_OA;
                    p0_transpose_item(w_out, DM, DM, WoutT, 0, scr, m, lane1);
                }
            }
        }
    }
    const int NQ = (ATT_NQ8 && F.G % 8 == 0) ? 8 : 1, xq = (NQ == 8) ? (int)(blockIdx.x & 7) : 0, QLEN = 896 / NQ;
    int have_first = 0;
    if (blockIdx.x >= 8) {
        have_first = 1;
        if (F.wave == 0) { if (F.lane == 0) F.MISC[16] = __hip_atomic_fetch_add((unsigned*)(F.ctl + CW_QUEUE + 32 * xq), 1u, __ATOMIC_RELAXED, __HIP_MEMORY_SCOPE_AGENT); }
    }
    xcd_barrier(bar);
    TS(2);

    {
        if (blockIdx.x < 8) {
            const int pn = (int)blockIdx.x; int n_two = 2, n_one = 1; asm volatile("" : "+s"(n_two), "+s"(n_one));
            item_wait(F.ctl + CW_DONE_S, 128u, F.ctl + CW_TMO);
            {
                pg8::Gemm g{(const bf16*)(ws + WS_GATED), (const bf16*)(ws + WS_WOT), 2 * MT, 4096, 1024}; pg8::MergeOne S{pn, n_two};
                pg8::EpiMerge E{ws, WS_MMS - (size_t)SEQ * 2048 * 2};
                pg8::gemm_phase<pg8::EpiMerge, pg8::MergeOne, true, true>(F.lds + RING_OFF, g, S, E);
            }
            item_done(F.ctl + CW_DONE_M3);
            item_wait(F.ctl + CW_DONE_M3, 8u, F.ctl + CW_TMO);
            {
                pg8::Gemm g{(const bf16*)(ws + WS_MMS), (const bf16*)(ws + WS_WOUTT), 256, DM, DM}; pg8::OutOne S{pn, n_one};
                pg8::EpiOutNorm E{args.in[1], out + O_Y + (size_t)SEQ * DM, args.in[8], (float*)(ws + WS_SS) + (size_t)SEQ * 32, (unsigned*)(F.ctl + CW_PANEL + 64 * 32), (unsigned*)(F.ctl + CW_TMO)};
                pg8::gemm_phase<pg8::EpiOutNorm, pg8::OutOne, false, true>(F.lds + RING_OFF, g, S, E);
            }
        }
        const float* subln = args.in[14];
        LAS float* tab = (LAS float*)(F.lds + TAB_OFF);
        const float lam = __builtin_bit_cast(float, (unsigned)F.MISC[20]);
        LAS float* wsf = (LAS float*)(F.lds + WSF_OFF) + F.wave * 64;
        const int w = F.wave, g = w >> 2, j = w & 3;
#if PROBE_MULT
        if (F.wave == 0) { if (F.lane == 0) { F.MISC[16] = 0xFFFFFFFFu; F.MISC[40] = (unsigned)wall_clock64(); } }
#endif
        int pend = 0;
        for (;;) {
            asm volatile("s_waitcnt vmcnt(0)" ::: "memory");
            __syncthreads();
            if (F.wave == 0) {
                if (F.lane == 0) {
                    if (pend) { __builtin_amdgcn_fence(__ATOMIC_RELEASE, "agent"); asm volatile("s_waitcnt vmcnt(0)" ::: "memory"); __hip_atomic_fetch_add(F.ctl + CW_DONE_S, 1u, RLX_AGENT); }
#if PROBE_MULT
                    { const unsigned tn = (unsigned)wall_clock64(), pu = F.MISC[16]; const int pk = (pu == 0xFFFFFFFFu) ? 4 : (pu < 64u) ? 1 : (pu < 128u) ? 3 : (pu < 584u) ? 0 : (pu < 840u) ? 2 : 0;
                      F.MISC[32 + pk] += tn - F.MISC[40]; F.MISC[40] = tn; }
#endif
                    if (!have_first) F.MISC[16] = __hip_atomic_fetch_add((unsigned*)(F.ctl + CW_QUEUE + 32 * xq), 1u, __ATOMIC_RELAXED, __HIP_MEMORY_SCOPE_AGENT);
                }
            }
            __syncthreads();
            const int ui = __builtin_amdgcn_readfirstlane((int)F.MISC[16]);
            have_first = 0;
            __syncthreads();
            if (ui >= QLEN) {
#if PROBE_MULT
                if (F.wave == 0) { if (F.lane == 0) { const unsigned long long t_ = wall_clock64(); gu32* pb = F.ctl + 12288 + 8 * blockIdx.x; pb[6] = (unsigned)t_; pb[7] = (unsigned)(t_ >> 32);
                    for (int k = 0; k < 5; ++k) pb[k] = F.MISC[32 + k]; } }
#endif
                break;
            }
            const int h = (NQ == 8) ? xq : ui % 8, u = (NQ == 8) ? ui : ui / 8;
            int kind, q;
            if (u < 16) { kind = (u < 8) ? 1 : 3; q = u & 7; }
            else if (u < 73) { kind = 0; q = 63 - (u - 16); }
            else if (u < 105) { kind = 2; q = 31 - (u - 73); }
            else { kind = 0; q = 6 - (u - 105); }
            att::UnitP U; U.hcol = h * 128; U.mask_tile = -1; U.kpos0 = 0; U.t_begin = 0;
            if (kind < 2) {
                const int row0 = (kind == 0) ? 128 * q + 32 * j : SEQ + 32 * q;
                U.qoff = (unsigned)WS_QA + (unsigned)(row0 * 1024 + h * 128 + g * 64) * 2u; U.qpos = (kind == 0) ? row0 : PAST; U.out_row0 = row0; U.tab = tab + h * 192; U.kc0 = 8 * g; U.vis_lo = 0; U.xslot = (kind == 0) ? j : 0;
                U.zoff = (unsigned)WS_ZA; U.ooff = (unsigned)WS_GATED;
                if (kind == 0) { U.koff = (unsigned)WS_KA + h * 256; U.voff = (unsigned)WS_VA + h * 256; U.t_end = 2 * q + 2; U.vis_hi = 2 * q + (j >> 1); }
                else { U.koff = (unsigned)WS_KAS + (unsigned)(q * KAS_ROWS * 1024 + h * 128) * 2u; U.voff = (unsigned)WS_VAS + (unsigned)(q * KAS_ROWS * 1024 + h * 128) * 2u; U.t_end = 33; U.vis_hi = (j == g) ? 32 : -1; U.mask_tile = 32; }
                att::attn_unit<0>(U, ws, F.lds + RING_OFF, wsf, lam, subln);
            } else {
                const int row0 = (kind == 2) ? 256 * q + 32 * w : SEQ + 32 * q;
                U.qoff = (unsigned)WS_QB + (unsigned)(row0 * 1024 + h * 128) * 2u; U.qpos = (kind == 2) ? row0 : PAST; U.out_row0 = row0; U.tab = tab + (8 + h) * 192; U.kc0 = 0;
                U.zoff = (unsigned)WS_ZB; U.ooff = (unsigned)(WS_GATED + (size_t)MT * 1024 * 2);
                if (kind == 2) { const int cw = 4 * q + (w >> 1); U.koff = (unsigned)WS_KB + h * 256; U.voff = (unsigned)WS_VB + h * 256; U.t_begin = (4 * q - 8 > 0) ? 4 * q - 8 : 0; U.t_end = 4 * q + 4; U.vis_lo = cw - 8; U.vis_hi = cw; }
                else { U.koff = (unsigned)WS_KBS + (unsigned)(q * KBS_ROWS * 1024 + h * 128) * 2u; U.voff = (unsigned)WS_VBS + (unsigned)(q * KBS_ROWS * 1024 + h * 128) * 2u; U.t_end = 9; U.vis_lo = 0; U.vis_hi = (w == 0) ? 8 : -1; U.mask_tile = 8; U.kpos0 = PAST - 512; }
                att::attn_unit<1>(U, ws, F.lds + RING_OFF, wsf, lam, subln);
            }
            pend = (kind & 1);
        }
    }
    xcd_barrier(bar);
    TS(3);

    for (int rep = 0; rep < REP_P3; ++rep) {
        pg8::Gemm g{(const bf16*)(ws + WS_GATED), (const bf16*)(ws + WS_WOT), 2 * MT, 4096, 1024}; pg8::MergeOrder S{F.vcu, F.G};
        pg8::EpiMerge E{ws, WS_MM};
        pg8::gemm_phase<pg8::EpiMerge, pg8::MergeOrder, true, true>(F.lds + RING_OFF, g, S, E);
    }
    xcd_barrier(bar);
    TS(4);

    for (int rep = 0; rep < REP_P4; ++rep) {
        pg8::Gemm g{(const bf16*)(ws + WS_MM), (const bf16*)(ws + WS_WOUTT), MT, DM, DM}; pg8::OutOrder S{F.vcu, F.G};
        pg8::EpiOutNorm E{args.in[0], out + O_Y, args.in[8], (float*)(ws + WS_SS), (unsigned*)(F.ctl + CW_PANEL), (unsigned*)(F.ctl + CW_TMO)};
        pg8::gemm_phase<pg8::EpiOutNorm, pg8::OutOrder, false, true>(F.lds + RING_OFF, g, S, E);
    }
#if PROBE_MULT
    asm volatile("s_waitcnt vmcnt(0)" ::: "memory");
    __syncthreads();
    TS(5);
    if (blockIdx.x == 0 && F.wave == 0) { if (F.lane == 0) {
        const unsigned long long ta = (unsigned long long)F.ctl[2048 + 2 * PROBE_A] | ((unsigned long long)F.ctl[2048 + 2 * PROBE_A + 1] << 32);
        const unsigned long long tb = (unsigned long long)F.ctl[2048 + 2 * PROBE_B] | ((unsigned long long)F.ctl[2048 + 2 * PROBE_B + 1] << 32);
        const unsigned long long t5 = (unsigned long long)F.ctl[2048 + 10] | ((unsigned long long)F.ctl[2048 + 11] << 32);
#if PROBE_A == 9
        unsigned long long sum = 0;
        for (int b = 0; b < (int)gridDim.x; ++b) { const unsigned long long te = (unsigned long long)__hip_atomic_load(F.ctl + 12288 + 8 * b + 6, RLX_AGENT) | ((unsigned long long)__hip_atomic_load(F.ctl + 12288 + 8 * b + 7, RLX_AGENT) << 32); sum += tb - te; }
        const unsigned long long d = sum * (unsigned long long)PROBE_MULT / gridDim.x;
#elif PROBE_A == 8
        const unsigned long long ca = (unsigned long long)F.ctl[2112 + 2 * (PROBE_B - 1)] | ((unsigned long long)F.ctl[2112 + 2 * (PROBE_B - 1) + 1] << 32);
        const unsigned long long cb = (unsigned long long)F.ctl[2112 + 2 * PROBE_B] | ((unsigned long long)F.ctl[2112 + 2 * PROBE_B + 1] << 32);
        const unsigned long long d = (cb - ca) / 20ull * (unsigned long long)PROBE_MULT;
#elif PROBE_A >= 10
        unsigned long long sum = 0;
        for (int b = 0; b < (int)gridDim.x; ++b) sum += __hip_atomic_load(F.ctl + 12288 + 8 * b + (PROBE_A - 10), RLX_AGENT);
        const unsigned long long d = sum * (unsigned long long)PROBE_MULT / gridDim.x;
#else
        const unsigned long long d = (tb - ta) * (unsigned long long)PROBE_MULT;
#endif
        while (wall_clock64() - t5 < d) __builtin_amdgcn_s_sleep(16);
    } }
#endif
}

extern "C" void kernel_launch(void* const* d_in, const int* in_sizes, int n_in, void* d_out, int out_size, void* d_ws, size_t ws_size, hipStream_t stream) {
    static int grid = 0;
    if (grid == 0) {
        if (n_in != 19 || out_size != 44040192 || ws_size < WS_END) { fprintf(stderr, "kernel_launch: unexpected problem (n_in %d, out %d, ws %zu)\n", n_in, out_size, ws_size); grid = -1; return; }
        int dev = 0, cus = 0, per_cu = 0;
        if (hipGetDevice(&dev) != hipSuccess || hipDeviceGetAttribute(&cus, hipDeviceAttributeMultiprocessorCount, dev) != hipSuccess) { grid = -1; return; }
        if (hipFuncSetAttribute((const void*)fwd_kernel, hipFuncAttributeMaxDynamicSharedMemorySize, LDS_BYTES) != hipSuccess) { fprintf(stderr, "kernel_launch: hipFuncSetAttribute failed\n"); grid = -1; return; }
        if (hipOccupancyMaxActiveBlocksPerMultiprocessor(&per_cu, (const void*)fwd_kernel, NWAVES * 64, LDS_BYTES) != hipSuccess || per_cu < 1) { fprintf(stderr, "kernel_launch: occupancy query says %d blocks per CU\n", per_cu); grid = -1; (void)hipGetLastError(); return; }
        (void)hipGetLastError();
        grid = cus;
    }
    if (grid < 0) return;
    (void)hipMemsetAsync((char*)d_ws + WS_CTL, 0, CTL_ZERO_BYTES, stream);
    Args a{};
    for (int i = 0; i < 19; ++i) a.in[i] = (const float*)d_in[i];
    a.out = (float*)d_out; a.ws = (unsigned char*)d_ws;
    hipLaunchKernelGGL(fwd_kernel, dim3(grid), dim3(NWAVES * 64), LDS_BYTES, stream, a);
}
```
